# Optimizing an MI355X kernel written in HIP

```python
import jax, jax.numpy as jnp
from jax import lax
import numpy as np

D_MODEL = 1024
BATCH = 16
SEQ = 4096
DEPTH = 2
DEC_BATCH = 16
DEC_SEQ = 16
PAST_LEN = 2048

CHUNK = 64
Q_BLOCK = 128
D_PLE = 256
N_HEADS_A = 8
QK_NOPE = 64
QK_ROPE = 32
V_HEAD = 64
KV_LORA = 128
Q_LORA = 256
WIDTH_A = N_HEADS_A * V_HEAD
CONV_CH = D_MODEL // 2
CONV_W = 31
CONV_STATE = CONV_W - 1
D_MIX = WIDTH_A + CONV_CH
D_IN = Q_LORA + KV_LORA + QK_ROPE + WIDTH_A + 2 * CONV_CH + CONV_CH
ROPE_THETA = 10000.0
ATTN_SCALE = (QK_NOPE + QK_ROPE) ** -0.5
EPS = 1e-6
NEG_INF = -1e30

kernel_name = "hymba_mla_conformer_stream_step"


def rmsnorm(x, g):
    xf = x.astype(jnp.float32)
    y = xf * lax.rsqrt(jnp.mean(xf * xf, axis=-1, keepdims=True) + EPS)
    return (y * g.astype(jnp.float32)).astype(x.dtype)


def layernorm(x, g, b):
    xf = x.astype(jnp.float32)
    mu = jnp.mean(xf, axis=-1, keepdims=True)
    xc = xf - mu
    var = jnp.mean(xc * xc, axis=-1, keepdims=True)
    y = xc * lax.rsqrt(var + EPS) * g.astype(jnp.float32) + b.astype(jnp.float32)
    return y.astype(x.dtype)


def rope(x, pos):
    half = QK_ROPE // 2
    inv = ROPE_THETA ** (-jnp.arange(half, dtype=jnp.float32) / half)
    ang = pos.astype(jnp.float32)[:, None] * inv[None, :]
    cos = jnp.cos(ang)[None, :, None, :]
    sin = jnp.sin(ang)[None, :, None, :]
    x1 = x[..., :half].astype(jnp.float32)
    x2 = x[..., half:].astype(jnp.float32)
    return jnp.concatenate([x1 * cos - x2 * sin, x1 * sin + x2 * cos], axis=-1).astype(x.dtype)


def mla_attend(q_lat, q_rope, ckv, krope, mask):
    s = (jnp.einsum('bthr,bsr->bhts', q_lat, ckv)
         + jnp.einsum('bthe,bse->bhts', q_rope, krope)).astype(jnp.float32) * ATTN_SCALE
    if mask is not None:
        s = jnp.where(mask[None, None], s, NEG_INF)
    p = jax.nn.softmax(s, axis=-1).astype(ckv.dtype)
    return jnp.einsum('bhts,bsr->bthr', p, ckv)


def prompt_attention(q_lat, q_rope, ckv, krope):
    b, t = q_lat.shape[0], q_lat.shape[1]
    nb = t // Q_BLOCK
    ql = q_lat.reshape(b, nb, Q_BLOCK, N_HEADS_A, KV_LORA).transpose(1, 0, 2, 3, 4)
    qr = q_rope.reshape(b, nb, Q_BLOCK, N_HEADS_A, QK_ROPE).transpose(1, 0, 2, 3, 4)
    k_chunk = jnp.arange(t) // CHUNK

    def block(args):
        ql_b, qr_b, i = args
        q_chunk = (i * Q_BLOCK + jnp.arange(Q_BLOCK)) // CHUNK
        mask = k_chunk[None, :] <= q_chunk[:, None]
        return mla_attend(ql_b, qr_b, ckv, krope, mask)

    o = lax.map(block, (ql, qr, jnp.arange(nb)))
    return o.transpose(1, 0, 2, 3, 4).reshape(b, t, N_HEADS_A, KV_LORA)


def causal_dwconv(u_pad, w, bias):
    y = lax.conv_general_dilated(u_pad, w[:, None, :], window_strides=(1,), padding='VALID',
                                 dimension_numbers=('NWC', 'WIO', 'NWC'),
                                 feature_group_count=CONV_CH)
    return y + bias


def mixer_layer(h, p, pos, ckv_past, krope_past, conv_past,
                ln_in, w_in, ln_q, w_q_b, ln_kv, w_kv_b, conv_w, conv_b,
                ln_conv_g, ln_conv_b, ln_out_a, ln_out_c, w_out, w_pe, ln_pg, w_pg):
    b, t = h.shape[0], h.shape[1]
    z = rmsnorm(h, ln_in) @ w_in
    i1 = Q_LORA
    i2 = i1 + KV_LORA
    i3 = i2 + QK_ROPE
    i4 = i3 + WIDTH_A
    i5 = i4 + CONV_CH
    i6 = i5 + CONV_CH
    c_q, c_kv, k_r, g_a, u_val, u_gate, g_c = jnp.split(z, [i1, i2, i3, i4, i5, i6], axis=-1)

    q = (rmsnorm(c_q, ln_q) @ w_q_b).reshape(b, t, N_HEADS_A, QK_NOPE + QK_ROPE)
    q_nope = q[..., :QK_NOPE]
    q_rope = rope(q[..., QK_NOPE:], pos)
    ckv_new = rmsnorm(c_kv, ln_kv)
    kr_new = rope(k_r[:, :, None, :], pos)[:, :, 0, :]
    w_kv = w_kv_b.reshape(KV_LORA, N_HEADS_A, QK_NOPE + V_HEAD)
    w_uk = w_kv[..., :QK_NOPE]
    w_uv = w_kv[..., QK_NOPE:]
    q_lat = jnp.einsum('bthn,rhn->bthr', q_nope, w_uk)
    if ckv_past is None:
        o_lat = prompt_attention(q_lat, q_rope, ckv_new, kr_new)
    else:
        o_lat = mla_attend(q_lat, q_rope,
                           jnp.concatenate([ckv_past, ckv_new], axis=1),
                           jnp.concatenate([krope_past, kr_new], axis=1), None)
    o_a = jnp.einsum('bthr,rhv->bthv', o_lat, w_uv).reshape(b, t, WIDTH_A)
    y_a = rmsnorm(o_a * jax.nn.silu(g_a), ln_out_a)

    u = u_val * jax.nn.sigmoid(u_gate)
    if conv_past is None:
        past = jnp.zeros((b, CONV_STATE, CONV_CH), u.dtype)
    else:
        past = conv_past
    u_pad = jnp.concatenate([past, u], axis=1)
    v = causal_dwconv(u_pad, conv_w, conv_b)
    v = jax.nn.silu(layernorm(v, ln_conv_g, ln_conv_b))
    y_c = rmsnorm(v * jax.nn.silu(g_c), ln_out_c)
    conv_state = u_pad[:, -CONV_STATE:, :]

    h = h + jnp.concatenate([y_a, y_c], axis=-1) @ w_out
    gate = jax.nn.sigmoid(rmsnorm(h, ln_pg) @ w_pg)
    h = h + gate * (p @ w_pe)
    return h, ckv_new, kr_new, conv_state


def setup_inputs(seed: int = 0) -> dict:
    key = jax.random.key(seed)
    ks = jax.random.split(key, 24)
    f32 = jnp.float32

    def nrm(k, shape, scale=1.0):
        return jax.random.normal(k, shape, f32) * scale

    def gain(k, shape):
        return 1.0 + 0.05 * jax.random.normal(k, shape, f32)

    return {
        'x_prompt': nrm(ks[0], (BATCH, SEQ, D_MODEL)),
        'x_sample': nrm(ks[1], (DEC_BATCH, DEC_SEQ, D_MODEL)),
        'cache_ckv': nrm(ks[2], (DEPTH, DEC_BATCH, PAST_LEN, KV_LORA)),
        'cache_krope': nrm(ks[3], (DEPTH, DEC_BATCH, PAST_LEN, QK_ROPE)),
        'state_conv': nrm(ks[4], (DEPTH, DEC_BATCH, CONV_STATE, CONV_CH), 0.5),
        'p_prompt': nrm(ks[5], (DEPTH, BATCH, SEQ, D_PLE)),
        'p_sample': nrm(ks[6], (DEPTH, DEC_BATCH, DEC_SEQ, D_PLE)),
        'ln_in': gain(ks[7], (DEPTH, D_MODEL)),
        'w_in': nrm(ks[8], (DEPTH, D_MODEL, D_IN), D_MODEL ** -0.5),
        'ln_q': gain(ks[9], (DEPTH, Q_LORA)),
        'w_q_b': nrm(ks[10], (DEPTH, Q_LORA, N_HEADS_A * (QK_NOPE + QK_ROPE)), Q_LORA ** -0.5),
        'ln_kv': gain(ks[11], (DEPTH, KV_LORA)),
        'w_kv_b': nrm(ks[12], (DEPTH, KV_LORA, N_HEADS_A * (QK_NOPE + V_HEAD)), KV_LORA ** -0.5),
        'conv_w': nrm(ks[13], (DEPTH, CONV_W, CONV_CH), CONV_W ** -0.5),
        'conv_b': nrm(ks[14], (DEPTH, CONV_CH), 0.01),
        'ln_conv_g': gain(ks[15], (DEPTH, CONV_CH)),
        'ln_conv_b': nrm(ks[16], (DEPTH, CONV_CH), 0.01),
        'ln_out_a': gain(ks[17], (DEPTH, WIDTH_A)),
        'ln_out_c': gain(ks[18], (DEPTH, CONV_CH)),
        'w_out': nrm(ks[19], (DEPTH, D_MIX, D_MODEL), D_MIX ** -0.5),
        'w_pe': nrm(ks[20], (DEPTH, D_PLE, D_MODEL), D_PLE ** -0.5),
        'ln_pg': gain(ks[21], (DEPTH, D_MODEL)),
        'w_pg': nrm(ks[22], (DEPTH, D_MODEL, D_MODEL), D_MODEL ** -0.5),
        'ln_f': gain(ks[23], (D_MODEL,)),
    }


def reference(x_prompt, x_sample, cache_ckv, cache_krope, state_conv, p_prompt, p_sample,
              ln_in, w_in, ln_q, w_q_b, ln_kv, w_kv_b, conv_w, conv_b, ln_conv_g, ln_conv_b,
              ln_out_a, ln_out_c, w_out, w_pe, ln_pg, w_pg, ln_f):
    past_len = cache_ckv.shape[2]
    pos_p = jnp.arange(x_prompt.shape[1])
    pos_s = past_len + jnp.arange(x_sample.shape[1])
    h_p = x_prompt
    h_s = x_sample
    ckv_p, kr_p, cv_p, ckv_s, kr_s, cv_s = [], [], [], [], [], []
    for i in range(DEPTH):
        lw = (ln_in[i], w_in[i], ln_q[i], w_q_b[i], ln_kv[i], w_kv_b[i], conv_w[i], conv_b[i],
              ln_conv_g[i], ln_conv_b[i], ln_out_a[i], ln_out_c[i], w_out[i], w_pe[i],
              ln_pg[i], w_pg[i])
        h_p, a, b_, c = mixer_layer(h_p, p_prompt[i], pos_p, None, None, None, *lw)
        ckv_p.append(a)
        kr_p.append(b_)
        cv_p.append(c)
        h_s, a, b_, c = mixer_layer(h_s, p_sample[i], pos_s, cache_ckv[i], cache_krope[i],
                                    state_conv[i], *lw)
        ckv_s.append(a)
        kr_s.append(b_)
        cv_s.append(c)
    y_prompt = rmsnorm(h_p, ln_f)
    y_sample = rmsnorm(h_s, ln_f)
    return (y_prompt, y_sample,
            jnp.stack(ckv_p), jnp.stack(kr_p), jnp.stack(cv_p),
            jnp.stack(ckv_s), jnp.stack(kr_s), jnp.stack(cv_s))
```

```cpp
#include <hip/hip_runtime.h>
#include <hip/hip_cooperative_groups.h>
#include <cstdio>
#include <cstdint>
#include <cmath>
namespace cg = cooperative_groups;

#define LAS __attribute__((address_space(3)))
typedef unsigned short bf16_t;
typedef short bf16x8 __attribute__((ext_vector_type(8)));
typedef float f32x4 __attribute__((ext_vector_type(4)));
typedef float f32x2 __attribute__((ext_vector_type(2)));
typedef float f32x16 __attribute__((ext_vector_type(16)));
typedef unsigned u32x4 __attribute__((ext_vector_type(4)));
typedef unsigned u32x2 __attribute__((ext_vector_type(2)));

constexpr int DM = 1024, SEQ = 4096, NP = 65536, NS = 256, MROWS = NP + NS, DEPTH = 2;
constexpr int PAST = 2048, KVS = 2064, KVSP = 2112, DPLE = 256;
constexpr int NIN = 2560, NQ = 1280, DIN = 2464;
constexpr float EPS = 1e-6f;
constexpr float QSCALE = 0.10206207261596575f * 1.4426950408889634f;

constexpr size_t O_Y = 0, O_CKVP = 67371008, O_KRP = 84148224, O_CVP = 88342528, O_CKVS = 88834048, O_KRS = 88899584, O_CVS = 88915968;

constexpr size_t MiB = 1u << 20;
constexpr size_t WS_CTL = 0;
constexpr size_t WS_ROPE = 1 * MiB;
constexpr size_t WS_WIN = 2 * MiB;
constexpr size_t WS_WQ = 12 * MiB;
constexpr size_t WS_WOUT = 14 * MiB;
constexpr size_t WS_WPG = 18 * MiB;
constexpr size_t WS_WPE = 22 * MiB;
constexpr size_t WS_WUV = 23 * MiB;
constexpr size_t WS_PARTA = 24 * MiB;
constexpr size_t WS_PARTB = 29 * MiB;
constexpr size_t WS_PARTQ = 34 * MiB;
constexpr size_t WS_SSQA = 36 * MiB;
constexpr size_t WS_HBA = 39 * MiB;
constexpr size_t WS_Q = 168 * MiB;
constexpr size_t WS_CQ = 329 * MiB;
constexpr size_t WS_SGA = 362 * MiB;
constexpr size_t WS_U = 427 * MiB;
constexpr size_t WS_SGC = 492 * MiB;
constexpr size_t WS_CAT = 557 * MiB;
constexpr size_t WS_PE = 686 * MiB;
constexpr size_t WS_PB = 815 * MiB;
constexpr size_t WS_KP = 881 * MiB;
constexpr size_t WS_VTP = 921 * MiB;
constexpr size_t WS_KS = 953 * MiB;
constexpr size_t WS_VTS = 975 * MiB;
constexpr size_t WS_FOLD = 993 * MiB;
constexpr size_t WS_END = 995 * MiB;
constexpr size_t KP_LAYER = (size_t)NP * 160, VTP_LAYER = (size_t)16 * 128 * SEQ;
constexpr size_t KS_LAYER = (size_t)16 * KVSP * 160, VTS_LAYER = (size_t)16 * 128 * KVSP;

constexpr int LDS_BYTES = 147456;
constexpr int LDS_EXTRA = 131072;

struct Params {
    const float* in[24];
    float* out;
    unsigned char* ws;
    float inv[16];
};

typedef const __attribute__((address_space(4))) Params KParams;
#define KP_FRESH() ({ KParams* _p = (KParams*)__builtin_amdgcn_kernarg_segment_ptr(); asm volatile("" : "+s"(_p)); _p; })
__device__ __forceinline__ float wave_sum(float v) {
#pragma unroll
    for (int o = 1; o < 64; o <<= 1) v += __shfl_xor(v, o);
    return v;
}
typedef __bf16 bf16x2_t __attribute__((ext_vector_type(2)));
__device__ __forceinline__ unsigned cvt_pk_bf16(float lo, float hi) { f32x2 v = {lo, hi}; bf16x2_t b = __builtin_convertvector(v, bf16x2_t); return __builtin_bit_cast(unsigned, b); }
__device__ __forceinline__ float bf_lo(unsigned w) { return __uint_as_float(w << 16); }
__device__ __forceinline__ float bf_hi(unsigned w) { return __uint_as_float(w & 0xffff0000u); }
__device__ __forceinline__ float sigmoid_(float x) { return __builtin_amdgcn_rcpf(1.f + __expf(-x)); }
__device__ __forceinline__ float silu_(float x) { return x * sigmoid_(x); }
__device__ __forceinline__ int swap23(int p) { return (p & ~12) | ((p & 4) << 1) | ((p & 8) >> 1); }

namespace pg8 {
constexpr int BM = 256, BK = 64, HALF = 128, HTB = HALF * BK * 2, STAGE_BYTES = 8 * HTB, NXCD = 8, WGM = 8;
__host__ __device__ __forceinline__ int lds_byte(int r, int c) { const int st = (r >> 4) * 2 + (c >> 5), rr = r & 15, cc = c & 31, ob = rr * 64 + cc * 2; return st * 1024 + (ob ^ (((ob >> 9) & 1) << 5)); }
__host__ __device__ __forceinline__ void stage_rc(int b, int& R, int& C) { const int st = b / 1024, sb = b % 1024, swz = sb ^ (((sb >> 9) & 1) << 5); R = (st >> 1) * 16 + swz / 64; C = (st & 1) * 32 + (swz % 64) / 2; }
__host__ __device__ __forceinline__ int perm32(int rho) { const int n = rho >> 4, i = rho & 15; return 8 * (i >> 2) + 4 * n + (i & 3); }

struct Unit { int pm, pn; };
struct Gemm { const bf16_t* A; const bf16_t* Bt; int M, N, K; };

struct StaticOrder {
    int nM, nN, nwg, G, c;
    __device__ void init(int M, int N, int G_, int c_) { nM = M / BM; nN = N / BM; nwg = nM * nN; G = G_; c = c_; }
    __device__ bool next(int i, Unit& u) const {
        const long L = (long)i * G + c; if (L >= nwg) return false;
        int wgid = (int)L; { const int q = nwg / NXCD, r = nwg % NXCD, xcd = wgid % NXCD, off = wgid / NXCD; wgid = (xcd < r ? xcd * (q + 1) : r * (q + 1) + (xcd - r) * q) + off; }
        const int nig = WGM * nN, gid = wgid / nig, fm = gid * WGM, gsz = (nM - fm) < WGM ? (nM - fm) : WGM;
        u.pm = fm + ((wgid % nig) % gsz); u.pn = (wgid % nig) / gsz; return true;
    }
};

template <class Epi>
__device__ __forceinline__ void gemm_phase(LAS unsigned char* lds, const Gemm g, const StaticOrder& S, const Epi& E) {
    int tid = threadIdx.x; asm volatile("" : "+v"(tid));
    const int wid = __builtin_amdgcn_readfirstlane(tid >> 6), lane = tid & 63, wr = wid >> 2, wc = wid & 3, fr = lane & 15, fq = lane >> 4;
    int K = g.K; asm volatile("" : "+s"(K)); const int nt = K / BK;
    LAS float* rsl = (LAS float*)(lds + LDS_EXTRA);
    unsigned voffA[2], voffB[2];
#pragma unroll
    for (int i = 0; i < 2; ++i) { int R, C; stage_rc(tid * 16 + i * 8192, R, C); const int Rb = (R & ~31) + perm32(R & 31);
        voffA[i] = (unsigned)(R * K + C) * 2u; voffB[i] = (unsigned)(Rb * K + C) * 2u; }
    const size_t kstep = (size_t)(BK * 2);
    const size_t hstep = (size_t)HALF * K * 2;
    const size_t tstep = 2 * hstep;
    const unsigned ldsw = (unsigned)wid * 1024u;
    const int aoff = lds_byte(wr * 64 + fr, fq * 8), boff = lds_byte(wc * 32 + fr, fq * 8);
#define PG8_SA(b, h) (((b) * 2 + (h)) * HTB)
#define PG8_SB(b, h) ((4 + (b) * 2 + (h)) * HTB)
#define PG8_STAGE(bufoff, gbase, voff) do { _Pragma("unroll") for (int _i = 0; _i < 2; ++_i) \
        __builtin_amdgcn_global_load_lds((const unsigned*)((const char*)(gbase) + (voff)[_i]), (LAS unsigned*)(lds + (bufoff) + ldsw + _i * 8192), 16, 0, 0); } while (0)
#define PG8_LDA(dst, b, h) do { _Pragma("unroll") for (int m = 0; m < 4; ++m) _Pragma("unroll") for (int k = 0; k < 2; ++k) dst[m][k] = *(const LAS bf16x8*)(lds + PG8_SA(b, h) + aoff + m * 2048 + k * 1024); } while (0)
#define PG8_LDB(dst, b, h) do { _Pragma("unroll") for (int n = 0; n < 2; ++n) _Pragma("unroll") for (int k = 0; k < 2; ++k) dst[n][k] = *(const LAS bf16x8*)(lds + PG8_SB(b, h) + boff + n * 2048 + k * 1024); } while (0)
#define PG8_MMA(ai, bj, At, Bt) do { __builtin_amdgcn_s_setprio(1); _Pragma("unroll") for (int m = 0; m < 4; ++m) _Pragma("unroll") for (int n = 0; n < 2; ++n) _Pragma("unroll") for (int k = 0; k < 2; ++k) \
        acc[ai][bj][m][n] = __builtin_amdgcn_mfma_f32_16x16x32_bf16(Bt[n][k], At[m][k], acc[ai][bj][m][n], 0, 0, 0); __builtin_amdgcn_s_setprio(0); } while (0)
#define PG8_WAIT_V(n) asm volatile("s_waitcnt vmcnt(" #n ")" ::: "memory")
#define PG8_WAIT_L(n) asm volatile("s_waitcnt lgkmcnt(" #n ")" ::: "memory")
#define PG8_BAR __builtin_amdgcn_s_barrier()
#define PG8_SCHED __builtin_amdgcn_sched_barrier(0)
    Unit cur, nxt; int ui = 0;
    if (!S.next(0, cur)) return;
    f32x4 acc[2][2][4][2];
#pragma unroll
    for (int a = 0; a < 2; ++a)
#pragma unroll
        for (int b = 0; b < 2; ++b)
#pragma unroll
            for (int m = 0; m < 4; ++m)
#pragma unroll
                for (int n = 0; n < 2; ++n) acc[a][b][m][n] = (f32x4){0.f, 0.f, 0.f, 0.f};
    bf16x8 At[4][2], B0[2][2], B1[2][2];
    const char* cA = (const char*)g.A + (size_t)cur.pm * tstep; const char* cB = (const char*)g.Bt + (size_t)cur.pn * tstep;
    E.prep(cur, 0, rsl, tid);
    PG8_STAGE(PG8_SB(0, 0), cB, voffB); PG8_STAGE(PG8_SB(0, 1), cB + hstep, voffB); PG8_STAGE(PG8_SA(0, 0), cA, voffA); PG8_STAGE(PG8_SA(0, 1), cA + hstep, voffA);
    if (wr == 1) PG8_BAR;
    PG8_WAIT_V(2); PG8_BAR;
    PG8_STAGE(PG8_SB(1, 0), cB + kstep, voffB); PG8_STAGE(PG8_SA(1, 0), cA + kstep, voffA); PG8_STAGE(PG8_SB(1, 1), cB + hstep + kstep, voffB);
    PG8_WAIT_V(6); PG8_BAR;
    for (;;) {
        const bool has_next = S.next(ui + 1, nxt);
        const char* nA = has_next ? (const char*)g.A + (size_t)nxt.pm * tstep : cA; const char* nB = has_next ? (const char*)g.Bt + (size_t)nxt.pn * tstep : cB;
#pragma unroll 1
        for (int t = 0; t < nt; t += 2) {
            const bool last = (t == nt - 2);
            const char* a1 = cA + (size_t)(t + 1) * kstep;
            const char* a2 = last ? nA : cA + (size_t)(t + 2) * kstep; const char* b2 = last ? nB : cB + (size_t)(t + 2) * kstep;
            const char* a3 = a2 + kstep; const char* b3 = b2 + kstep;
            if (last && has_next) E.prep(nxt, (ui + 1) & 1, rsl, tid);
            PG8_LDB(B0, 0, 0); PG8_LDB(B1, 0, 1); PG8_SCHED; PG8_LDA(At, 0, 0); PG8_STAGE(PG8_SA(1, 1), a1 + hstep, voffA);
            PG8_WAIT_V(8); PG8_WAIT_L(0); PG8_BAR; PG8_MMA(0, 0, At, B0); PG8_MMA(0, 1, At, B1); PG8_BAR; PG8_SCHED;
            PG8_LDA(At, 0, 1); PG8_STAGE(PG8_SB(0, 0), b2, voffB); PG8_STAGE(PG8_SB(0, 1), b2 + hstep, voffB); PG8_STAGE(PG8_SA(0, 0), a2, voffA);
            PG8_WAIT_V(8); PG8_WAIT_L(0); PG8_BAR; PG8_MMA(1, 0, At, B0); PG8_MMA(1, 1, At, B1); PG8_BAR; PG8_SCHED;
            PG8_LDB(B0, 1, 0); PG8_LDB(B1, 1, 1); PG8_SCHED; PG8_LDA(At, 1, 0); PG8_STAGE(PG8_SA(0, 1), a2 + hstep, voffA);
            PG8_WAIT_V(8); PG8_WAIT_L(0); PG8_BAR; PG8_MMA(0, 0, At, B0); PG8_MMA(0, 1, At, B1); PG8_BAR; PG8_SCHED;
            PG8_LDA(At, 1, 1); PG8_STAGE(PG8_SB(1, 0), b3, voffB); PG8_STAGE(PG8_SB(1, 1), b3 + hstep, voffB); PG8_STAGE(PG8_SA(1, 0), a3, voffA);
            PG8_WAIT_V(8); PG8_WAIT_L(0); PG8_BAR; PG8_MMA(1, 0, At, B0); PG8_MMA(1, 1, At, B1); PG8_BAR; PG8_SCHED;
        }
        if (wr == 0) PG8_BAR;
        E(acc, cur, ui & 1, rsl, wr, wc, fr, fq);
        if (!has_next) break;
#pragma unroll
        for (int a = 0; a < 2; ++a)
#pragma unroll
            for (int b = 0; b < 2; ++b)
#pragma unroll
                for (int m = 0; m < 4; ++m)
#pragma unroll
                    for (int n = 0; n < 2; ++n) acc[a][b][m][n] = (f32x4){0.f, 0.f, 0.f, 0.f};
        cur = nxt; cA = nA; cB = nB; ++ui;
        if (wr == 1) PG8_BAR;
    }
    PG8_WAIT_V(0);
    PG8_BAR;
#undef PG8_SA
#undef PG8_SB
#undef PG8_STAGE
#undef PG8_LDA
#undef PG8_LDB
#undef PG8_MMA
#undef PG8_WAIT_V
#undef PG8_WAIT_L
#undef PG8_BAR
#undef PG8_SCHED
}
}
using pg8::Unit;

#define EPI_ROWS(...) \
    _Pragma("unroll") for (int ai = 0; ai < 2; ++ai) _Pragma("unroll") for (int m = 0; m < 4; ++m) { \
        const int rl = ai * 128 + wr * 64 + m * 16 + fr; const int row = u.pm * 256 + rl; __VA_ARGS__ if (m == 3) asm volatile("" ::: "memory"); }

__device__ __forceinline__ u32x4 pack8(f32x4 a, f32x4 b) { u32x4 w; w.x = cvt_pk_bf16(a[0], a[1]); w.y = cvt_pk_bf16(a[2], a[3]); w.z = cvt_pk_bf16(b[0], b[1]); w.w = cvt_pk_bf16(b[2], b[3]); return w; }
__device__ __forceinline__ float sumsq8(f32x4 a, f32x4 b) { return (a[0] * a[0] + a[1] * a[1]) + (a[2] * a[2] + a[3] * a[3]) + (b[0] * b[0] + b[1] * b[1]) + (b[2] * b[2] + b[3] * b[3]); }
__device__ __forceinline__ float red_fq(float s) { s += __shfl_xor(s, 16); s += __shfl_xor(s, 32); return s; }

struct EpiIn {
    const float* part_in;
    bf16_t* cq; float* part_q; float* ckv_p; float* ckv_s; float* kr_p; float* kr_s; bf16_t* sga; bf16_t* uu; bf16_t* sgc;
    __device__ __forceinline__ void prep(const Unit& u, int par, LAS float* rsl, int tid) const {
        if (tid < 256) { const int row = u.pm * 256 + tid; float s = 0.f;
#pragma unroll
            for (int j = 0; j < 4; ++j) { const f32x4 p = *(const f32x4*)(part_in + (size_t)row * 16 + 4 * j); s += (p[0] + p[1]) + (p[2] + p[3]); }
            rsl[par * 256 + tid] = rsqrtf(s * (1.0f / 1024.0f) + EPS); }
    }
    __device__ __forceinline__ void operator()(const f32x4 (&acc)[2][2][4][2], const Unit& u, int par, LAS float* rsl, int wr, int wc, int fr, int fq) const {
        const int pn = u.pn; const int cw = wc * 32 + 8 * fq;
        if (pn == 0) {
            EPI_ROWS( const float rs = rsl[par * 256 + rl]; float ss = 0.f;
                _Pragma("unroll") for (int bj = 0; bj < 2; ++bj) { const f32x4 v0 = acc[ai][bj][m][0] * rs, v1 = acc[ai][bj][m][1] * rs; ss += sumsq8(v0, v1);
                    *(u32x4*)(cq + (size_t)row * 256 + bj * 128 + cw) = pack8(v0, v1); }
                ss = red_fq(ss); if (fq == 0) part_q[(size_t)row * 4 + wc] = ss; )
        } else if (pn == 1) {
            EPI_ROWS( const float rs = rsl[par * 256 + rl];
                { float* d = (row < NP ? ckv_p + (size_t)row * 128 : ckv_s + (size_t)(row - NP) * 128) + cw;
                  *(f32x4*)d = acc[ai][0][m][0] * rs; *(f32x4*)(d + 4) = acc[ai][0][m][1] * rs; }
                if (wc == 0) { float* d = (row < NP ? kr_p + (size_t)row * 32 : kr_s + (size_t)(row - NP) * 32) + 8 * fq;
                  *(f32x4*)d = acc[ai][1][m][0] * rs; *(f32x4*)(d + 4) = acc[ai][1][m][1] * rs; } )
        } else if (pn < 4 || pn >= 8) {
            bf16_t* dst = (pn < 4) ? sga + (pn - 2) * 256 : sgc + (pn - 8) * 256;
            EPI_ROWS( const float rs = rsl[par * 256 + rl];
                _Pragma("unroll") for (int bj = 0; bj < 2; ++bj) { f32x4 v0 = acc[ai][bj][m][0] * rs, v1 = acc[ai][bj][m][1] * rs;
                    _Pragma("unroll") for (int e = 0; e < 4; ++e) { v0[e] = silu_(v0[e]); v1[e] = silu_(v1[e]); }
                    *(u32x4*)(dst + (size_t)row * 512 + bj * 128 + cw) = pack8(v0, v1); } )
        } else {
            bf16_t* dst = uu + (pn - 4) * 128;
            EPI_ROWS( const float rs = rsl[par * 256 + rl];
                f32x4 v0 = acc[ai][0][m][0] * rs, v1 = acc[ai][0][m][1] * rs; const f32x4 g0 = acc[ai][1][m][0] * rs, g1 = acc[ai][1][m][1] * rs;
                _Pragma("unroll") for (int e = 0; e < 4; ++e) { v0[e] *= sigmoid_(g0[e]); v1[e] *= sigmoid_(g1[e]); }
                *(u32x4*)(dst + (size_t)row * 512 + cw) = pack8(v0, v1); )
        }
    }
};

struct EpiQ {
    const float* part_q; bf16_t* Q; const float* cosT; const float* sinT;
    __device__ __forceinline__ void prep(const Unit& u, int par, LAS float* rsl, int tid) const {
        if (tid < 256) { const int row = u.pm * 256 + tid; const f32x4 p = *(const f32x4*)(part_q + (size_t)row * 4);
            rsl[par * 256 + tid] = rsqrtf(((p[0] + p[1]) + (p[2] + p[3])) * (1.0f / 256.0f) + EPS) * QSCALE; }
    }
    __device__ __forceinline__ void operator()(const f32x4 (&acc)[2][2][4][2], const Unit& u, int par, LAS float* rsl, int wr, int wc, int fr, int fq) const {
        const int pn = u.pn; const int cw = wc * 32 + 8 * fq;
        if (pn < 4) {
            EPI_ROWS( const float rs = rsl[par * 256 + rl];
                _Pragma("unroll") for (int bj = 0; bj < 2; ++bj)
                    *(u32x4*)(Q + (size_t)row * NQ + pn * 256 + bj * 128 + cw) = pack8(acc[ai][bj][m][0] * rs, acc[ai][bj][m][1] * rs); )
        } else {
            EPI_ROWS( const float rs = rsl[par * 256 + rl];
                const int pos = row < NP ? (row & (SEQ - 1)) : PAST + ((row - NP) & 15);
                const f32x4 cs = *(const f32x4*)(cosT + pos * 16 + 4 * fq), sn = *(const f32x4*)(sinT + pos * 16 + 4 * fq);
                _Pragma("unroll") for (int bj = 0; bj < 2; ++bj) { const f32x4 x1 = acc[ai][bj][m][0] * rs, x2 = acc[ai][bj][m][1] * rs;
                    const f32x4 o1 = x1 * cs - x2 * sn, o2 = x1 * sn + x2 * cs; const int head = bj * 4 + wc;
                    bf16_t* d = Q + (size_t)row * NQ + 1024 + head * 32 + 4 * fq;
                    u32x2 w1, w2; w1.x = cvt_pk_bf16(o1[0], o1[1]); w1.y = cvt_pk_bf16(o1[2], o1[3]); w2.x = cvt_pk_bf16(o2[0], o2[1]); w2.y = cvt_pk_bf16(o2[2], o2[3]);
                    *(u32x2*)d = w1; *(u32x2*)(d + 16) = w2; } )
        }
    }
};

struct EpiPe {
    bf16_t* pe;
    __device__ __forceinline__ void prep(const Unit&, int, LAS float*, int) const {}
    __device__ __forceinline__ void operator()(const f32x4 (&acc)[2][2][4][2], const Unit& u, int par, LAS float* rsl, int wr, int wc, int fr, int fq) const {
        const int cw = u.pn * 256 + wc * 32 + 8 * fq;
        EPI_ROWS(
            _Pragma("unroll") for (int bj = 0; bj < 2; ++bj) *(u32x4*)(pe + (size_t)row * DM + bj * 128 + cw) = pack8(acc[ai][bj][m][0], acc[ai][bj][m][1]); )
    }
};

struct EpiOut {
    const float* base_p; const float* base_s; const bf16_t* base_b; bf16_t* hb; float* part;
    __device__ __forceinline__ void prep(const Unit&, int, LAS float*, int) const {}
    __device__ __forceinline__ void operator()(const f32x4 (&acc)[2][2][4][2], const Unit& u, int par, LAS float* rsl, int wr, int wc, int fr, int fq) const {
        const int cw = u.pn * 256 + wc * 32 + 8 * fq;
        if (base_b == nullptr) {
            EPI_ROWS( const float* b = (row < NP ? base_p + (size_t)row * DM : base_s + (size_t)(row - NP) * DM) + cw; float ss = 0.f;
                _Pragma("unroll") for (int bj = 0; bj < 2; ++bj) { const f32x4 v0 = acc[ai][bj][m][0] + *(const f32x4*)(b + bj * 128), v1 = acc[ai][bj][m][1] + *(const f32x4*)(b + bj * 128 + 4);
                    *(u32x4*)(hb + (size_t)row * DM + bj * 128 + cw) = pack8(v0, v1); ss += sumsq8(v0, v1); }
                ss = red_fq(ss); if (fq == 0) part[(size_t)row * 16 + u.pn * 4 + wc] = ss; )
        } else {
            EPI_ROWS( float ss = 0.f;
                _Pragma("unroll") for (int bj = 0; bj < 2; ++bj) { const size_t off = (size_t)row * DM + bj * 128 + cw; const u32x4 bw = *(const u32x4*)(base_b + off);
                    const f32x4 v0 = acc[ai][bj][m][0] + (f32x4){bf_lo(bw.x), bf_hi(bw.x), bf_lo(bw.y), bf_hi(bw.y)}, v1 = acc[ai][bj][m][1] + (f32x4){bf_lo(bw.z), bf_hi(bw.z), bf_lo(bw.w), bf_hi(bw.w)};
                    *(u32x4*)(hb + off) = pack8(v0, v1); ss += sumsq8(v0, v1); }
                ss = red_fq(ss); if (fq == 0) part[(size_t)row * 16 + u.pn * 4 + wc] = ss; )
        }
    }
};

struct EpiGate {
    const float* part_in; const bf16_t* pe; const bf16_t* hin; bf16_t* hb; float* part;
    __device__ __forceinline__ void prep(const Unit& u, int par, LAS float* rsl, int tid) const {
        if (tid < 256) { const int row = u.pm * 256 + tid; float s = 0.f;
#pragma unroll
            for (int j = 0; j < 4; ++j) { const f32x4 p = *(const f32x4*)(part_in + (size_t)row * 16 + 4 * j); s += (p[0] + p[1]) + (p[2] + p[3]); }
            rsl[par * 256 + tid] = rsqrtf(s * (1.0f / 1024.0f) + EPS); }
    }
    __device__ __forceinline__ void operator()(const f32x4 (&acc)[2][2][4][2], const Unit& u, int par, LAS float* rsl, int wr, int wc, int fr, int fq) const {
        const int cw = u.pn * 256 + wc * 32 + 8 * fq;
        EPI_ROWS( const float rs = rsl[par * 256 + rl]; float ss = 0.f;
            _Pragma("unroll") for (int bj = 0; bj < 2; ++bj) { const size_t off = (size_t)row * DM + bj * 128 + cw;
                const u32x4 pw = *(const u32x4*)(pe + off); const u32x4 hw = *(const u32x4*)(hin + off);
                const f32x4 a0 = acc[ai][bj][m][0] * rs, a1 = acc[ai][bj][m][1] * rs; f32x4 v0, v1;
                v0[0] = bf_lo(hw.x) + sigmoid_(a0[0]) * bf_lo(pw.x); v0[1] = bf_hi(hw.x) + sigmoid_(a0[1]) * bf_hi(pw.x); v0[2] = bf_lo(hw.y) + sigmoid_(a0[2]) * bf_lo(pw.y); v0[3] = bf_hi(hw.y) + sigmoid_(a0[3]) * bf_hi(pw.y);
                v1[0] = bf_lo(hw.z) + sigmoid_(a1[0]) * bf_lo(pw.z); v1[1] = bf_hi(hw.z) + sigmoid_(a1[1]) * bf_hi(pw.z); v1[2] = bf_lo(hw.w) + sigmoid_(a1[2]) * bf_lo(pw.w); v1[3] = bf_hi(hw.w) + sigmoid_(a1[3]) * bf_hi(pw.w);
                *(u32x4*)(hb + off) = pack8(v0, v1); ss += sumsq8(v0, v1); }
            ss = red_fq(ss); if (fq == 0) part[(size_t)row * 16 + u.pn * 4 + wc] = ss; )
    }
};

__device__ __forceinline__ int in_src(int n) {
    if (n < 256) return n;
    if (n < 512) { const int j = n - 256; return j < 160 ? 256 + j : -1; }
    if (n < 1024) return 416 + (n - 512);
    if (n < 2048) { const int tt = (n - 1024) >> 8, j = (n - 1024) & 255; return j < 128 ? 928 + tt * 128 + j : 1440 + tt * 128 + (j - 128); }
    return 1952 + (n - 2048);
}
struct SrcIn { const float* w; const float* g; __device__ __forceinline__ float operator()(int k, int n) const { const int s = in_src(n); return s < 0 ? 0.f : w[(size_t)k * DIN + s] * g[k]; } };
struct SrcQ { const float* wq; const float* fold; const float* g;
    __device__ __forceinline__ float operator()(int k, int n) const {
        if (n < 1024) return fold[(size_t)k * 1024 + n];
        const int j = n - 1024, head = j >> 5, p = j & 31, ridx = (p >> 3) * 4 + (p & 3) + 16 * ((p >> 2) & 1);
        return wq[(size_t)k * 768 + head * 96 + 64 + ridx] * g[k];
    } };
struct SrcPlain { const float* w; int N; const float* g; __device__ __forceinline__ float operator()(int k, int n) const { const float v = w[(size_t)k * N + n]; return g ? v * g[k] : v; } };

template <class F>
__device__ __forceinline__ void transpose_w(const F& src, int K, int Nout, bf16_t* WT, LAS float* scr, int gw, int NGW, int lane) {
    const int nblk = Nout / 32, items = (K / 64) * nblk;
    for (int it = gw; it < items; it += NGW) {
        const int kb = it / nblk, nb = it % nblk, k0 = kb * 64, n0 = nb * 32;
#pragma unroll 4
        for (int i = 0; i < 32; ++i) { const int kk = 2 * i + (lane >> 5); scr[kk * 33 + (lane & 31)] = src(k0 + kk, n0 + (lane & 31)); }
        const int c = lane & 7;
#pragma unroll
        for (int j = 0; j < 4; ++j) { const int n = (lane >> 3) + 8 * j; const LAS float* s = scr + (8 * c) * 33 + n;
            u32x4 o; o.x = cvt_pk_bf16(s[0 * 33], s[1 * 33]); o.y = cvt_pk_bf16(s[2 * 33], s[3 * 33]); o.z = cvt_pk_bf16(s[4 * 33], s[5 * 33]); o.w = cvt_pk_bf16(s[6 * 33], s[7 * 33]);
            *(u32x4*)(WT + (size_t)(n0 + n) * K + k0 + 8 * c) = o; }
    }
}

__device__ __forceinline__ void vt_flush(const LAS float* scr, bf16_t* vt, size_t pitch, int t0, int lane) {
#pragma unroll
    for (int dd = 0; dd < 2; ++dd) { const int d = lane + 64 * dd; bf16_t* dst = vt + (size_t)d * pitch + t0;
#pragma unroll
        for (int q = 0; q < 4; ++q) { u32x4 w;
            w.x = cvt_pk_bf16(scr[(8 * q + 0) * 128 + d], scr[(8 * q + 1) * 128 + d]); w.y = cvt_pk_bf16(scr[(8 * q + 2) * 128 + d], scr[(8 * q + 3) * 128 + d]);
            w.z = cvt_pk_bf16(scr[(8 * q + 4) * 128 + d], scr[(8 * q + 5) * 128 + d]); w.w = cvt_pk_bf16(scr[(8 * q + 6) * 128 + d], scr[(8 * q + 7) * 128 + d]);
            *(u32x4*)(dst + 8 * q) = w; } }
}

__device__ __forceinline__ void p0_prologue(KParams& P, LAS unsigned char* lds) {
    int tid = threadIdx.x; asm volatile("" : "+v"(tid)); const int lane = tid & 63, gw = blockIdx.x * 8 + (tid >> 6), NGW = gridDim.x * 8;
    unsigned char* ws = P.ws;
    LAS float* scr = (LAS float*)(lds + (tid >> 6) * 16384);
    if (blockIdx.x == 0 && tid < 64) { unsigned* ctl = (unsigned*)(ws + WS_CTL); for (int j = tid; j < 16 * 64; j += 64) ctl[j] = 0u; }
    { float* fold = (float*)(ws + WS_FOLD);
      for (int it = gw; it < DEPTH * 8 * 32 * 2; it += NGW) { const int rb = it & 1, kc = (it >> 1) & 31, h = (it >> 6) & 7, l = it >> 9; const int r = rb * 64 + lane, k0 = kc * 8;
          const float* bp = P.in[12] + (size_t)l * 128 * 1024 + (size_t)r * 1024 + h * 128; f32x4 bv[16];
#pragma unroll
          for (int j = 0; j < 16; ++j) bv[j] = *(const f32x4*)(bp + 4 * j);
#pragma unroll 1
          for (int kk = 0; kk < 8; ++kk) { const int k = k0 + kk; const float* ap = P.in[10] + (size_t)l * 256 * 768 + (size_t)k * 768 + h * 96; float sm = 0.f;
#pragma unroll
              for (int j = 0; j < 16; ++j) { const f32x4 av = *(const f32x4*)(ap + 4 * j); sm += (av[0] * bv[j][0] + av[1] * bv[j][1]) + (av[2] * bv[j][2] + av[3] * bv[j][3]); }
              fold[((size_t)l * 256 + k) * 1024 + h * 128 + r] = sm * P.in[9][l * 256 + k]; } } }
    { float* cosT = (float*)(ws + WS_ROPE); float* sinT = cosT + 4096 * 16;
      for (int e = gw * 64 + lane; e < 4096 * 16; e += NGW * 64) { const int pos = e >> 4, i = e & 15;
          const float ang = (float)pos * P.inv[i];
          double rev = (double)ang * 0.15915494309189535; rev -= floor(rev);
          cosT[e] = __builtin_amdgcn_cosf((float)rev); sinT[e] = __builtin_amdgcn_sinf((float)rev); } }
    for (int l = 0; l < DEPTH; ++l) {
        { SrcIn s{P.in[8] + (size_t)l * DM * DIN, P.in[7] + l * DM}; transpose_w(s, DM, NIN, (bf16_t*)(ws + WS_WIN) + (size_t)l * NIN * DM, scr, gw, NGW, lane); }
        { SrcPlain s{P.in[19] + (size_t)l * DM * DM, DM, nullptr}; transpose_w(s, DM, DM, (bf16_t*)(ws + WS_WOUT) + (size_t)l * DM * DM, scr, gw, NGW, lane); }
        { SrcPlain s{P.in[22] + (size_t)l * DM * DM, DM, P.in[21] + l * DM}; transpose_w(s, DM, DM, (bf16_t*)(ws + WS_WPG) + (size_t)l * DM * DM, scr, gw, NGW, lane); }
        { SrcPlain s{P.in[20] + (size_t)l * DPLE * DM, DM, nullptr}; transpose_w(s, DPLE, DM, (bf16_t*)(ws + WS_WPE) + (size_t)l * DM * DPLE, scr, gw, NGW, lane); }
    }
    { bf16_t* wuv = (bf16_t*)(ws + WS_WUV);
      for (int e = gw * 64 + lane; e < DEPTH * 8 * 64 * 128; e += NGW * 64) { const int p = e & 127, v = (e >> 7) & 63, h = (e >> 13) & 7, l = e >> 16;
          const float x = P.in[12][(size_t)l * 128 * 1024 + (size_t)swap23(p) * 1024 + h * 128 + 64 + v]; wuv[e] = (bf16_t)(cvt_pk_bf16(x, 0.f) & 0xffffu); } }
    { bf16_t* hba = (bf16_t*)(ws + WS_HBA); float* part = (float*)(ws + WS_PARTA);
      for (int row0 = gw; row0 < MROWS; row0 += 4 * NGW) { f32x4 a[4][4]; float sq[4];
#pragma unroll
          for (int u = 0; u < 4; ++u) { const int row = row0 + u * NGW < MROWS ? row0 + u * NGW : row0;
              const float* xa = row < NP ? P.in[0] + (size_t)row * DM : P.in[1] + (size_t)(row - NP) * DM;
#pragma unroll
              for (int j = 0; j < 4; ++j) a[u][j] = *(const f32x4*)(xa + 4 * (lane + 64 * j)); }
#pragma unroll
          for (int u = 0; u < 4; ++u) { const int row = row0 + u * NGW; const bool ok = row < MROWS; float s1 = 0.f;
#pragma unroll
              for (int j = 0; j < 4; ++j) { s1 += (a[u][j][0] * a[u][j][0] + a[u][j][1] * a[u][j][1]) + (a[u][j][2] * a[u][j][2] + a[u][j][3] * a[u][j][3]);
                  if (ok) { u32x2 w; w.x = cvt_pk_bf16(a[u][j][0], a[u][j][1]); w.y = cvt_pk_bf16(a[u][j][2], a[u][j][3]); *(u32x2*)(hba + (size_t)row * DM + 4 * (lane + 64 * j)) = w; } }
              sq[u] = s1; }
#pragma unroll
          for (int o = 1; o < 64; o <<= 1)
#pragma unroll
              for (int u = 0; u < 4; ++u) sq[u] += __shfl_xor(sq[u], o);
#pragma unroll
          for (int u = 0; u < 4; ++u) { const int row = row0 + u * NGW; if (row < MROWS && lane < 16) part[(size_t)row * 16 + lane] = lane == 0 ? sq[u] : 0.f; } } }
    { bf16_t* pb = (bf16_t*)(ws + WS_PB);
      for (int r0 = gw; r0 < DEPTH * MROWS; r0 += 8 * NGW) { f32x4 v[8];
#pragma unroll
          for (int u = 0; u < 8; ++u) { const int r = r0 + u * NGW; if (r < DEPTH * MROWS) { const int l = r / MROWS, row = r % MROWS;
              const float* pr = row < NP ? P.in[5] + ((size_t)l * NP + row) * DPLE : P.in[6] + ((size_t)l * NS + (row - NP)) * DPLE; v[u] = *(const f32x4*)(pr + 4 * lane); } }
#pragma unroll
          for (int u = 0; u < 8; ++u) { const int r = r0 + u * NGW; if (r < DEPTH * MROWS) { u32x2 w; w.x = cvt_pk_bf16(v[u][0], v[u][1]); w.y = cvt_pk_bf16(v[u][2], v[u][3]); *(u32x2*)(pb + (size_t)r * DPLE + 4 * lane) = w; } } } }
    { bf16_t* ks = (bf16_t*)(ws + WS_KS); bf16_t* vts = (bf16_t*)(ws + WS_VTS);
      for (int it = gw; it < DEPTH * 16 * 64; it += NGW) { const int tb = it & 63, sb = (it >> 6) & 15, l = it >> 10, t0 = tb * 32;
          const float* cc = P.in[2] + ((size_t)(l * 16 + sb) * PAST + t0) * 128; const float* cr = P.in[3] + ((size_t)(l * 16 + sb) * PAST + t0) * 32;
          bf16_t* kd = ks + (size_t)l * KS_LAYER + ((size_t)sb * KVSP + t0) * 160;
#pragma unroll 1
          for (int i0 = 0; i0 < 32; i0 += 8) { f32x2 c[8], r[8];
#pragma unroll
              for (int u = 0; u < 8; ++u) { c[u] = *(const f32x2*)(cc + (i0 + u) * 128 + 2 * lane); r[u] = *(const f32x2*)(cr + (i0 + u) * 32 + 2 * (lane & 15)); }
#pragma unroll
              for (int u = 0; u < 8; ++u) { const int i = i0 + u; *(unsigned*)(kd + i * 160 + 2 * lane) = cvt_pk_bf16(c[u][0], c[u][1]);
                  scr[i * 128 + 2 * lane] = c[u][0]; scr[i * 128 + 2 * lane + 1] = c[u][1];
                  if (lane < 16) *(unsigned*)(kd + i * 160 + 128 + 2 * lane) = cvt_pk_bf16(r[u][0], r[u][1]); } }
          vt_flush(scr, vts + (size_t)l * VTS_LAYER + (size_t)sb * 128 * KVSP, KVSP, t0, lane); }
      for (int e = gw * 64 + lane; e < DEPTH * 16 * 48 * 160; e += NGW * 64) { const int c = e % 160, t = (e / 160) % 48, sb = (e / (160 * 48)) % 16, l = e / (160 * 48 * 16);
          ks[(size_t)l * KS_LAYER + ((size_t)sb * KVSP + KVS + t) * 160 + c] = 0; }
      for (int e = gw * 64 + lane; e < DEPTH * 16 * 128 * 48; e += NGW * 64) { const int t = e % 48, d = (e / 48) % 128, sb = (e / (48 * 128)) % 16, l = e / (48 * 128 * 16);
          vts[(size_t)l * VTS_LAYER + ((size_t)sb * 128 + d) * KVSP + KVS + t] = 0; } }
}

__device__ __forceinline__ void p0b_wq(KParams& P, LAS unsigned char* lds) {
    int tid = threadIdx.x; asm volatile("" : "+v"(tid)); const int lane = tid & 63, gw = blockIdx.x * 8 + (tid >> 6), NGW = gridDim.x * 8;
    unsigned char* ws = P.ws; LAS float* scr = (LAS float*)(lds + (tid >> 6) * 16384);
    for (int l = 0; l < DEPTH; ++l) { SrcQ s{P.in[10] + (size_t)l * 256 * 768, (const float*)(ws + WS_FOLD) + (size_t)l * 256 * 1024, P.in[9] + l * 256};
        transpose_w(s, 256, NQ, (bf16_t*)(ws + WS_WQ) + (size_t)l * NQ * 256, scr, (gw + l * 1024) % NGW, NGW, lane); }
}
__device__ __forceinline__ void kv_row_regs(KParams& P, int l, f32x2 c, float x1, float x2, float cs, float sn, float* ckv, float* kr, bf16_t* krow, LAS float* scr_row, int lane) {
    const float ss = wave_sum(c[0] * c[0] + c[1] * c[1]); const float rs = rsqrtf(ss * (1.0f / 128.0f) + EPS);
    const f32x2 g = *(const f32x2*)(P.in[11] + l * 128 + 2 * lane); const float v0 = c[0] * rs * g[0], v1 = c[1] * rs * g[1];
    *(f32x2*)(ckv + 2 * lane) = (f32x2){v0, v1}; *(unsigned*)(krow + 2 * lane) = cvt_pk_bf16(v0, v1);
    scr_row[2 * lane] = v0; scr_row[2 * lane + 1] = v1;
    if (lane < 16) { const float o1 = x1 * cs - x2 * sn, o2 = x1 * sn + x2 * cs;
        kr[lane] = o1; kr[16 + lane] = o2; krow[128 + lane] = (bf16_t)(cvt_pk_bf16(o1, 0.f) & 0xffffu); krow[144 + lane] = (bf16_t)(cvt_pk_bf16(o2, 0.f) & 0xffffu); }
}
__device__ __forceinline__ void kv_row(KParams& P, int l, int row, int pos, float* ckv, float* kr, bf16_t* krow, LAS float* scr_row, int lane) {
    const float* cosT = (const float*)(P.ws + WS_ROPE); const float* sinT = cosT + 4096 * 16;
    const f32x2 c = *(const f32x2*)(ckv + 2 * lane); const int l15 = lane & 15;
    kv_row_regs(P, l, c, kr[l15], kr[16 + l15], cosT[pos * 16 + l15], sinT[pos * 16 + l15], ckv, kr, krow, scr_row, lane);
}
__device__ __forceinline__ void kvprep_phase(KParams& P, int l, LAS unsigned char* lds) {
    int tid = threadIdx.x; asm volatile("" : "+v"(tid)); const int lane = tid & 63, gw = blockIdx.x * 8 + (tid >> 6), NGW = gridDim.x * 8;
    unsigned char* ws = P.ws; LAS float* scr = (LAS float*)(lds + (tid >> 6) * 16384);
    bf16_t* kp = (bf16_t*)(ws + WS_KP) + (size_t)l * KP_LAYER; bf16_t* vtp = (bf16_t*)(ws + WS_VTP) + (size_t)l * VTP_LAYER;
    float* ckvp = P.out + O_CKVP + (size_t)l * NP * 128; float* krp = P.out + O_KRP + (size_t)l * NP * 32;
    for (int it = gw; it < NP / 32; it += NGW) { const int r0 = it * 32, b = r0 >> 12, t0 = r0 & (SEQ - 1);
        const float* cosT = (const float*)(ws + WS_ROPE); const float* sinT = cosT + 4096 * 16; const int l15 = lane & 15;
#pragma unroll 1
        for (int i0 = 0; i0 < 32; i0 += 16) { f32x2 c[16]; float x1[16], x2[16], cs[16], sn[16];
#pragma unroll
            for (int u = 0; u < 16; ++u) { const int row = r0 + i0 + u; c[u] = *(const f32x2*)(ckvp + (size_t)row * 128 + 2 * lane);
                x1[u] = krp[(size_t)row * 32 + l15]; x2[u] = krp[(size_t)row * 32 + 16 + l15]; cs[u] = cosT[(t0 + i0 + u) * 16 + l15]; sn[u] = sinT[(t0 + i0 + u) * 16 + l15]; }
#pragma unroll
            for (int u = 0; u < 16; ++u) { const int i = i0 + u, row = r0 + i;
                kv_row_regs(P, l, c[u], x1[u], x2[u], cs[u], sn[u], ckvp + (size_t)row * 128, krp + (size_t)row * 32, kp + (size_t)row * 160, scr + i * 128, lane); } }
        vt_flush(scr, vtp + (size_t)b * 128 * SEQ, SEQ, t0, lane); }
    float* ckvs = P.out + O_CKVS + (size_t)l * NS * 128; float* krs = P.out + O_KRS + (size_t)l * NS * 32;
    bf16_t* ks = (bf16_t*)(ws + WS_KS) + (size_t)l * KS_LAYER; bf16_t* vts = (bf16_t*)(ws + WS_VTS) + (size_t)l * VTS_LAYER;
    for (int r = gw; r < NS; r += NGW) { const int sb = r >> 4, i = r & 15; bf16_t* krow = ks + ((size_t)sb * KVSP + PAST + i) * 160;
        kv_row(P, l, NP + r, PAST + i, ckvs + (size_t)r * 128, krs + (size_t)r * 32, krow, scr, lane);
        vts[((size_t)sb * 128 + 2 * lane) * KVSP + PAST + i] = (bf16_t)(cvt_pk_bf16(scr[2 * lane], 0.f) & 0xffffu);
        vts[((size_t)sb * 128 + 2 * lane + 1) * KVSP + PAST + i] = (bf16_t)(cvt_pk_bf16(scr[2 * lane + 1], 0.f) & 0xffffu); }
}

constexpr int KT_PITCH = 336, VT_PITCH = 144, KT_BYTES = 64 * KT_PITCH, ABUF = KT_BYTES + 128 * VT_PITCH;
struct AUnit { const bf16_t* K; const bf16_t* VT; int vt_pitch, nt, kvlen, qrow0, nq; };

__device__ __forceinline__ void attn_unit(KParams& P, int l, const AUnit& U, LAS unsigned char* lds) {
    int tid = threadIdx.x; asm volatile("" : "+v"(tid));
    const int lane = tid & 63, h = __builtin_amdgcn_readfirstlane(tid >> 6), i = lane & 31, hi = lane >> 5;
    unsigned char* ws = P.ws;
    const bf16_t* Qb = (const bf16_t*)(ws + WS_Q);
    const bool valid = i < U.nq; const int row = U.qrow0 + (valid ? i : 0);
    bf16x8 qf[10];
    { const bf16_t* qr = Qb + (size_t)row * NQ;
#pragma unroll
      for (int s = 0; s < 8; ++s) qf[s] = *(const bf16x8*)(qr + h * 128 + 16 * s + 8 * hi);
#pragma unroll
      for (int s = 0; s < 2; ++s) qf[8 + s] = *(const bf16x8*)(qr + 1024 + h * 32 + 16 * s + 8 * hi);
      if (!valid) {
#pragma unroll
          for (int s = 0; s < 10; ++s) qf[s] = (bf16x8){0, 0, 0, 0, 0, 0, 0, 0}; } }
    u32x4 st[5];
    const int kr1 = tid / 20, kc1 = tid % 20, kr2 = (tid + 512) / 20, kc2 = (tid + 512) % 20, kr3 = ((tid & 255) + 1024) / 20, kc3 = ((tid & 255) + 1024) % 20;
    const int vd1 = tid >> 3, vc = tid & 7, vd2 = vd1 + 64;
#define A_LOAD(t) do { const bf16_t* kb = U.K + (size_t)(t) * 64 * 160; const bf16_t* vb = U.VT + (size_t)(t) * 64; \
        st[0] = *(const u32x4*)(kb + kr1 * 160 + kc1 * 8); st[1] = *(const u32x4*)(kb + kr2 * 160 + kc2 * 8); st[2] = *(const u32x4*)(kb + kr3 * 160 + kc3 * 8); \
        st[3] = *(const u32x4*)(vb + (size_t)vd1 * U.vt_pitch + vc * 8); st[4] = *(const u32x4*)(vb + (size_t)vd2 * U.vt_pitch + vc * 8); } while (0)
#define A_STORE(buf) do { LAS unsigned char* bb = lds + (buf) * ABUF; \
        *(LAS u32x4*)(bb + kr1 * KT_PITCH + kc1 * 16) = st[0]; *(LAS u32x4*)(bb + kr2 * KT_PITCH + kc2 * 16) = st[1]; *(LAS u32x4*)(bb + kr3 * KT_PITCH + kc3 * 16) = st[2]; \
        *(LAS u32x4*)(bb + KT_BYTES + vd1 * VT_PITCH + vc * 16) = st[3]; *(LAS u32x4*)(bb + KT_BYTES + vd2 * VT_PITCH + vc * 16) = st[4]; } while (0)
    A_LOAD(0); A_STORE(0);
    __syncthreads();
    f32x16 o[4];
#pragma unroll
    for (int d = 0; d < 4; ++d)
#pragma unroll
        for (int r = 0; r < 16; ++r) o[d][r] = 0.f;
    float mrun = -1e30f, lrun = 0.f;
    const int koff = swap23(i) * KT_PITCH + 16 * hi, voff = KT_BYTES + i * VT_PITCH + 16 * hi;
    for (int t = 0; t < U.nt; ++t) {
        const bool more = t + 1 < U.nt;
        if (more) A_LOAD(t + 1);
        const LAS unsigned char* bb = lds + (t & 1) * ABUF;
        f32x16 p0, p1;
#pragma unroll
        for (int r = 0; r < 16; ++r) { p0[r] = 0.f; p1[r] = 0.f; }
#pragma unroll
        for (int s = 0; s < 10; ++s) {
            const bf16x8 k0 = *(const LAS bf16x8*)(bb + koff + 32 * s), k1 = *(const LAS bf16x8*)(bb + koff + 32 * KT_PITCH + 32 * s);
            p0 = __builtin_amdgcn_mfma_f32_32x32x16_bf16(k0, qf[s], p0, 0, 0, 0);
            p1 = __builtin_amdgcn_mfma_f32_32x32x16_bf16(k1, qf[s], p1, 0, 0, 0);
        }
        if ((t + 1) * 64 > U.kvlen) {
            const int kb0 = t * 64 + 8 * hi;
#pragma unroll
            for (int r = 0; r < 16; ++r) { const int kv = kb0 + 16 * (r >> 3) + (r & 7); if (kv >= U.kvlen) p0[r] = -INFINITY; if (kv + 32 >= U.kvlen) p1[r] = -INFINITY; }
        }
        float mx = fmaxf(p0[0], p1[0]);
#pragma unroll
        for (int r = 1; r < 16; ++r) mx = fmaxf(mx, fmaxf(p0[r], p1[r]));
        { const auto rr = __builtin_amdgcn_permlane32_swap(__float_as_uint(mx), __float_as_uint(mx), false, false);
          mx = fmaxf(__uint_as_float(rr[0]), __uint_as_float(rr[1])); }
        const float mnew = fmaxf(mrun, mx); const float f = __builtin_amdgcn_exp2f(mrun - mnew); const bool grew = __any(mnew > mrun); mrun = mnew;
        f32x2 ps2 = {0.f, 0.f}; const f32x2 nm2 = {-mnew, -mnew};
#pragma unroll
        for (int r = 0; r < 16; r += 2) { f32x2 a = (f32x2){p0[r], p0[r + 1]} + nm2, b = (f32x2){p1[r], p1[r + 1]} + nm2;
            a[0] = __builtin_amdgcn_exp2f(a[0]); a[1] = __builtin_amdgcn_exp2f(a[1]); b[0] = __builtin_amdgcn_exp2f(b[0]); b[1] = __builtin_amdgcn_exp2f(b[1]);
            p0[r] = a[0]; p0[r + 1] = a[1]; p1[r] = b[0]; p1[r + 1] = b[1]; ps2 += a; ps2 += b; }
        const float ps = ps2[0] + ps2[1];
        lrun = lrun * f + ps;
        if (grew) {
#pragma unroll
            for (int d = 0; d < 4; ++d)
#pragma unroll
                for (int r = 0; r < 16; ++r) o[d][r] *= f;
        }
        bf16x8 pf[4];
        { u32x4 w;
          w.x = cvt_pk_bf16(p0[0], p0[1]); w.y = cvt_pk_bf16(p0[2], p0[3]); w.z = cvt_pk_bf16(p0[4], p0[5]); w.w = cvt_pk_bf16(p0[6], p0[7]); pf[0] = __builtin_bit_cast(bf16x8, w);
          w.x = cvt_pk_bf16(p0[8], p0[9]); w.y = cvt_pk_bf16(p0[10], p0[11]); w.z = cvt_pk_bf16(p0[12], p0[13]); w.w = cvt_pk_bf16(p0[14], p0[15]); pf[1] = __builtin_bit_cast(bf16x8, w);
          w.x = cvt_pk_bf16(p1[0], p1[1]); w.y = cvt_pk_bf16(p1[2], p1[3]); w.z = cvt_pk_bf16(p1[4], p1[5]); w.w = cvt_pk_bf16(p1[6], p1[7]); pf[2] = __builtin_bit_cast(bf16x8, w);
          w.x = cvt_pk_bf16(p1[8], p1[9]); w.y = cvt_pk_bf16(p1[10], p1[11]); w.z = cvt_pk_bf16(p1[12], p1[13]); w.w = cvt_pk_bf16(p1[14], p1[15]); pf[3] = __builtin_bit_cast(bf16x8, w); }
#pragma unroll
        for (int d = 0; d < 4; ++d)
#pragma unroll
            for (int ks = 0; ks < 4; ++ks) {
                const bf16x8 vf = *(const LAS bf16x8*)(bb + voff + d * 32 * VT_PITCH + 32 * ks);
                o[d] = __builtin_amdgcn_mfma_f32_32x32x16_bf16(vf, pf[ks], o[d], 0, 0, 0);
            }
        if (more) A_STORE((t + 1) & 1);
        __syncthreads();
    }
#undef A_LOAD
#undef A_STORE
    const float ltot = lrun + __shfl_xor(lrun, 32); const float linv = __builtin_amdgcn_rcpf(ltot);
    bf16x8 of[8];
#pragma unroll
    for (int kk = 0; kk < 8; ++kk) { const int d = kk >> 1, b = 8 * (kk & 1); u32x4 w;
        w.x = cvt_pk_bf16(o[d][b + 0] * linv, o[d][b + 1] * linv); w.y = cvt_pk_bf16(o[d][b + 2] * linv, o[d][b + 3] * linv);
        w.z = cvt_pk_bf16(o[d][b + 4] * linv, o[d][b + 5] * linv); w.w = cvt_pk_bf16(o[d][b + 6] * linv, o[d][b + 7] * linv); of[kk] = __builtin_bit_cast(bf16x8, w); }
    const bf16_t* wuv = (const bf16_t*)(ws + WS_WUV) + ((size_t)(l * 8 + h) * 64) * 128;
    f32x16 oa[2];
#pragma unroll
    for (int vb = 0; vb < 2; ++vb) {
#pragma unroll
        for (int r = 0; r < 16; ++r) oa[vb][r] = 0.f;
#pragma unroll
        for (int kk = 0; kk < 8; ++kk) { const bf16x8 wf = *(const bf16x8*)(wuv + (size_t)(32 * vb + i) * 128 + 16 * kk + 8 * hi);
            oa[vb] = __builtin_amdgcn_mfma_f32_32x32x16_bf16(wf, of[kk], oa[vb], 0, 0, 0); }
    }
    const bf16_t* sga = (const bf16_t*)(ws + WS_SGA) + (size_t)row * 512 + h * 64;
    bf16_t* cat = (bf16_t*)(ws + WS_CAT) + (size_t)row * DM + h * 64;
    float ss = 0.f;
#pragma unroll
    for (int vb = 0; vb < 2; ++vb)
#pragma unroll
        for (int rg = 0; rg < 4; ++rg) { const int v = 32 * vb + 8 * rg + 4 * hi; const u32x2 gw = *(const u32x2*)(sga + v);
            oa[vb][4 * rg + 0] *= bf_lo(gw.x); oa[vb][4 * rg + 1] *= bf_hi(gw.x); oa[vb][4 * rg + 2] *= bf_lo(gw.y); oa[vb][4 * rg + 3] *= bf_hi(gw.y);
            ss += (oa[vb][4 * rg + 0] * oa[vb][4 * rg + 0] + oa[vb][4 * rg + 1] * oa[vb][4 * rg + 1]) + (oa[vb][4 * rg + 2] * oa[vb][4 * rg + 2] + oa[vb][4 * rg + 3] * oa[vb][4 * rg + 3]); }
    ss += __shfl_xor(ss, 32);
    LAS float* ssqL = (LAS float*)(lds + LDS_EXTRA + 13312);
    if (hi == 0) ssqL[h * 32 + i] = ss;
    __syncthreads();
    float tot = 0.f;
#pragma unroll
    for (int hh = 0; hh < 8; ++hh) tot += ssqL[hh * 32 + i];
    const float rsa = rsqrtf(tot * (1.0f / 512.0f) + EPS);
    const float* lna = P.in[17] + l * 512 + h * 64;
    if (valid) {
#pragma unroll
        for (int vb = 0; vb < 2; ++vb)
#pragma unroll
            for (int rg = 0; rg < 4; ++rg) { const int v = 32 * vb + 8 * rg + 4 * hi; const f32x4 g4 = *(const f32x4*)(lna + v);
                u32x2 w; w.x = cvt_pk_bf16(oa[vb][4 * rg + 0] * rsa * g4[0], oa[vb][4 * rg + 1] * rsa * g4[1]); w.y = cvt_pk_bf16(oa[vb][4 * rg + 2] * rsa * g4[2], oa[vb][4 * rg + 3] * rsa * g4[3]);
                *(u32x2*)(cat + v) = w; }
    }
}

__device__ __forceinline__ void attn_phase(KParams& P, int l, LAS unsigned char* lds) {
    unsigned char* ws = P.ws;
    unsigned* ctl = (unsigned*)(ws + WS_CTL);
    LAS int* slot = (LAS int*)(lds + LDS_EXTRA + 4096);
    const unsigned xcc = (unsigned)__builtin_amdgcn_s_getreg((3 << 11) | 20) & 7u;
    for (int k = 0; k < 8; ++k) {
        const int x = (int)((xcc + k) & 7u);
        for (;;) {
            if (threadIdx.x == 0) *slot = (int)__hip_atomic_fetch_add(ctl + (l * 8 + x) * 64, 1u, __ATOMIC_RELAXED, __HIP_MEMORY_SCOPE_AGENT);
            __syncthreads();
            const int idx = *slot;
            __syncthreads();
            if (idx >= 258) break;
            AUnit U;
            if (idx < 2) { const int sb = 2 * x + idx; U.K = (const bf16_t*)(ws + WS_KS) + (size_t)l * KS_LAYER + (size_t)sb * KVSP * 160;
                U.VT = (const bf16_t*)(ws + WS_VTS) + (size_t)l * VTS_LAYER + (size_t)sb * 128 * KVSP; U.vt_pitch = KVSP; U.nt = KVSP / 64; U.kvlen = KVS; U.qrow0 = NP + sb * 16; U.nq = 16; }
            else { const int j = idx - 2, b = 2 * x + (j & 1), g = 127 - (j >> 1);
                U.K = (const bf16_t*)(ws + WS_KP) + (size_t)l * KP_LAYER + (size_t)b * SEQ * 160; U.VT = (const bf16_t*)(ws + WS_VTP) + (size_t)l * VTP_LAYER + (size_t)b * 128 * SEQ; U.vt_pitch = SEQ;
                U.nt = (g >> 1) + 1; U.kvlen = SEQ; U.qrow0 = b * SEQ + g * 32; U.nq = 32; }
            attn_unit(P, l, U, lds);
        }
    }
}

constexpr int UL_ROWS = 62, VL_PITCH = 516, VL_OFF = UL_ROWS * 512 * 2;
__device__ __forceinline__ void conv_phase(KParams& P, int l, LAS unsigned char* lds) {
    unsigned char* ws = P.ws; int tid = threadIdx.x; asm volatile("" : "+v"(tid)); const int lane = tid & 63, wave = tid >> 6;
    const bf16_t* ub = (const bf16_t*)(ws + WS_U); const bf16_t* sgc = (const bf16_t*)(ws + WS_SGC);
    bf16_t* cat = (bf16_t*)(ws + WS_CAT);
    LAS bf16_t* uL = (LAS bf16_t*)lds; LAS float* vL = (LAS float*)(lds + VL_OFF);
    const int cp = tid & 255, th = tid >> 8;
    const float* cw = P.in[13] + (size_t)l * 31 * 512; const f32x2 bias2 = *(const f32x2*)(P.in[14] + l * 512 + 2 * cp);
    f32x2 w2[31];
#pragma unroll
    for (int k = 0; k < 31; ++k) w2[k] = *(const f32x2*)(cw + k * 512 + 2 * cp);
    const int c0 = lane * 8;
    f32x4 lg[2], lb[2], lc[2];
#pragma unroll
    for (int e = 0; e < 2; ++e) { lg[e] = *(const f32x4*)(P.in[15] + l * 512 + c0 + 4 * e); lb[e] = *(const f32x4*)(P.in[16] + l * 512 + c0 + 4 * e);
        lc[e] = *(const f32x4*)(P.in[18] + l * 512 + c0 + 4 * e); }
    for (int it = blockIdx.x; it < 2048 + 16; it += gridDim.x) {
        const bool samp = it >= 2048; const int b = samp ? it - 2048 : it >> 7, t0 = samp ? 0 : (it & 127) * 32;
        const size_t rowbase = samp ? (size_t)NP + b * 16 : (size_t)b * SEQ + t0;
        { u32x4 sv[8];
#pragma unroll
          for (int k = 0; k < 8; ++k) { const int idx = tid + 512 * k; const int j = idx >> 6, ch = idx & 63; u32x4 v = (u32x4){0u, 0u, 0u, 0u};
              if (idx < UL_ROWS * 64) {
                  if (!samp) { const int t = t0 - 30 + j; if (t >= 0) v = *(const u32x4*)(ub + ((size_t)b * SEQ + t) * 512 + ch * 8); }
                  else if (j < 30) { const float* sp = P.in[4] + ((size_t)(l * 16 + b) * 30 + j) * 512 + ch * 8; const f32x4 a = *(const f32x4*)sp, bq = *(const f32x4*)(sp + 4); v = pack8(a, bq); }
                  else if (j < 46) v = *(const u32x4*)(ub + ((size_t)NP + b * 16 + (j - 30)) * 512 + ch * 8); }
              sv[k] = v; }
#pragma unroll
          for (int k = 0; k < 8; ++k) { const int idx = tid + 512 * k; if (idx < UL_ROWS * 64) *(LAS u32x4*)(uL + (idx >> 6) * 512 + (idx & 63) * 8) = sv[k]; } }
        __syncthreads();
#pragma unroll 1
        for (int g = 0; g < 2; ++g) { const int tb = 16 * th + 8 * g;
            f32x2 x[38];
#pragma unroll
            for (int q = 0; q < 38; ++q) { const unsigned wv = *(const LAS unsigned*)(uL + (tb + q) * 512 + 2 * cp); x[q] = (f32x2){__uint_as_float(wv << 16), __uint_as_float(wv & 0xffff0000u)}; }
#pragma unroll
            for (int o = 0; o < 8; ++o) { f32x2 a = bias2;
#pragma unroll
                for (int k = 0; k < 31; ++k) a += w2[k] * x[o + k];
                *(LAS f32x2*)(vL + (tb + o) * VL_PITCH + 2 * cp) = a; }
        }
        if (!samp) { if (t0 == SEQ - 32) { float* cs = P.out + O_CVP + ((size_t)(l * 16 + b) * 30) * 512 + tid;
#pragma unroll 1
                for (int j = 0; j < 30; ++j) cs[(size_t)j * 512] = __uint_as_float((unsigned)uL[(32 + j) * 512 + tid] << 16); } }
        else { float* cs = P.out + O_CVS + ((size_t)(l * 16 + b) * 30) * 512 + tid; const float* s = P.in[4] + ((size_t)(l * 16 + b) * 30 + 16) * 512 + tid;
#pragma unroll 1
            for (int j = 0; j < 14; ++j) cs[(size_t)j * 512] = s[(size_t)j * 512];
#pragma unroll 1
            for (int j = 0; j < 16; ++j) cs[(size_t)(14 + j) * 512] = __uint_as_float((unsigned)uL[(30 + j) * 512 + tid] << 16); }
        __syncthreads();
        const int ntok = samp ? 16 : 32;
        u32x4 gqp[4];
#pragma unroll
        for (int ti = 0; ti < 4; ++ti) gqp[ti] = *(const u32x4*)(sgc + (rowbase + wave + 8 * ti) * 512 + c0);
#pragma unroll
        for (int ti = 0; ti < 4; ++ti) { const int tt = wave + 8 * ti; if (tt >= ntok) break; const size_t row = rowbase + tt;
            f32x4 v[2]; v[0] = *(const LAS f32x4*)(vL + tt * VL_PITCH + c0); v[1] = *(const LAS f32x4*)(vL + tt * VL_PITCH + c0 + 4);
            const float mean = wave_sum((v[0][0] + v[0][1]) + (v[0][2] + v[0][3]) + (v[1][0] + v[1][1]) + (v[1][2] + v[1][3])) * (1.0f / 512.0f);
            v[0] = v[0] - mean; v[1] = v[1] - mean;
            const float var = wave_sum(sumsq8(v[0], v[1])) * (1.0f / 512.0f); const float rstd = rsqrtf(var + EPS);
            const u32x4 gq = gqp[ti]; const float gcv[8] = {bf_lo(gq.x), bf_hi(gq.x), bf_lo(gq.y), bf_hi(gq.y), bf_lo(gq.z), bf_hi(gq.z), bf_lo(gq.w), bf_hi(gq.w)};
#pragma unroll
            for (int e = 0; e < 2; ++e)
#pragma unroll
                for (int q = 0; q < 4; ++q) { const float y = v[e][q] * rstd * lg[e][q] + lb[e][q]; v[e][q] = silu_(y) * gcv[4 * e + q]; }
            const float rs = rsqrtf(wave_sum(sumsq8(v[0], v[1])) * (1.0f / 512.0f) + EPS);
            *(u32x4*)(cat + row * DM + 512 + c0) = pack8(v[0] * rs * lc[0], v[1] * rs * lc[1]);
        }
        __syncthreads();
    }
}

__device__ __forceinline__ void final_phase(KParams& P) {
    int tid = threadIdx.x; asm volatile("" : "+v"(tid)); const int lane = tid & 63, gw = blockIdx.x * 8 + (tid >> 6), NGW = gridDim.x * 8;
    const float* g = P.in[23]; const bf16_t* hb = (const bf16_t*)(P.ws + WS_HBA);
    f32x4 gv[4];
#pragma unroll
    for (int j = 0; j < 4; ++j) gv[j] = *(const f32x4*)(g + 16 * lane + 4 * j);
    for (int row = gw; row < MROWS; row += 2 * NGW) { const int row2 = row + NGW; const bool has2 = row2 < MROWS;
        const u32x4 a0 = *(const u32x4*)(hb + (size_t)row * DM + 16 * lane), a1 = *(const u32x4*)(hb + (size_t)row * DM + 16 * lane + 8);
        u32x4 b0 = a0, b1 = a1; if (has2) { b0 = *(const u32x4*)(hb + (size_t)row2 * DM + 16 * lane); b1 = *(const u32x4*)(hb + (size_t)row2 * DM + 16 * lane + 8); }
#pragma unroll
        for (int u = 0; u < 2; ++u) { if (u == 1 && !has2) break; const u32x4 w0 = u ? b0 : a0, w1 = u ? b1 : a1; const int rr = u ? row2 : row;
            f32x4 v[4] = {{bf_lo(w0.x), bf_hi(w0.x), bf_lo(w0.y), bf_hi(w0.y)}, {bf_lo(w0.z), bf_hi(w0.z), bf_lo(w0.w), bf_hi(w0.w)}, {bf_lo(w1.x), bf_hi(w1.x), bf_lo(w1.y), bf_hi(w1.y)}, {bf_lo(w1.z), bf_hi(w1.z), bf_lo(w1.w), bf_hi(w1.w)}};
            float sq = 0.f;
#pragma unroll
            for (int j = 0; j < 4; ++j) sq += (v[j][0] * v[j][0] + v[j][1] * v[j][1]) + (v[j][2] * v[j][2] + v[j][3] * v[j][3]);
            const float rs = rsqrtf(wave_sum(sq) * (1.0f / 1024.0f) + EPS); float* xr = P.out + O_Y + (size_t)rr * DM + 16 * lane;
#pragma unroll
            for (int j = 0; j < 4; ++j) *(f32x4*)(xr + 4 * j) = v[j] * rs * gv[j]; } }
}

__device__ __forceinline__ void grid_barrier(cg::grid_group& grid) {
    asm volatile("s_waitcnt vmcnt(0) lgkmcnt(0)" ::: "memory");
    __syncthreads();
    if (threadIdx.x < 64) { __builtin_amdgcn_fence(__ATOMIC_RELEASE, "agent"); asm volatile("s_waitcnt vmcnt(0)" ::: "memory"); }
    grid.sync();
    __builtin_amdgcn_fence(__ATOMIC_ACQUIRE, "agent");
    asm volatile("s_waitcnt vmcnt(0)" ::: "memory");
    __syncthreads();
}


#define XB_TMO      128
#define XB_XCNT(j)  (256  + 64 * (j))
#define XB_XSUB(j)  (1280 + 64 * (j))
#define XB_XGEN(j)  (2304 + 64 * (j))
#define XB_TOP      3328
#define XB_TOPGEN   3392
#define XCD_BAR_WORDS 3456
#define XB_SPIN_CAP (1u << 18)
__device__ __forceinline__ unsigned xb_ld(unsigned* p)              { return __hip_atomic_load(p, __ATOMIC_RELAXED, __HIP_MEMORY_SCOPE_AGENT); }
__device__ __forceinline__ unsigned xb_add(unsigned* p, unsigned v) { return __hip_atomic_fetch_add(p, v, __ATOMIC_RELAXED, __HIP_MEMORY_SCOPE_AGENT); }
__device__ __forceinline__ unsigned xb_xcc_id() { return (unsigned)__builtin_amdgcn_s_getreg((3 << 11) | 20) & 0xFu; }
#define XB_SPIN(cond, bar) do { unsigned _sp = 0; while (cond) { __builtin_amdgcn_s_sleep(1); \
    if ((++_sp & 255u) == 0u) { if (xb_ld(&(bar)[XB_TMO])) break; if (_sp > XB_SPIN_CAP) { atomicAdd(&(bar)[XB_TMO], 1u); break; } } } } while (0)
struct XcdBarrier { unsigned* bar; unsigned x; volatile LAS unsigned* st; };
__device__ __forceinline__ XcdBarrier xcd_barrier_post(unsigned* bar, volatile LAS unsigned* st) {
    XcdBarrier b; b.bar = bar; b.x = xb_xcc_id(); b.st = st;
    if (threadIdx.x == 0) (void)xb_add(&bar[XB_XCNT(b.x)], 1u);
    return b;
}
__device__ __forceinline__ void xcd_barrier_complete(unsigned* bar, unsigned x, unsigned& nloc, unsigned& nx) {
    const unsigned G = gridDim.x * gridDim.y * gridDim.z;
    unsigned sum, cnt, mine, sp = 0u;
    for (;;) {
        sum = 0u; cnt = 0u; mine = 0u;
#pragma unroll
        for (unsigned j = 0; j < 16; ++j) { const unsigned c = xb_ld(&bar[XB_XCNT(j)]); sum += c; cnt += (c > 0u) ? 1u : 0u; mine = (j == x) ? c : mine; }
        if (sum == G) break;
        __builtin_amdgcn_s_sleep(1);
        if ((++sp & 255u) == 0u) { if (xb_ld(&bar[XB_TMO])) break; if (sp > XB_SPIN_CAP) { atomicAdd(&bar[XB_TMO], 1u); break; } }
    }
    nloc = mine > 0u ? mine : 1u; nx = cnt > 0u ? cnt : 1u;
}
__device__ __forceinline__ void xcd_barrier(const XcdBarrier& b) {
    asm volatile("s_waitcnt vmcnt(0)" ::: "memory");
    __syncthreads();
    if (threadIdx.x == 0) {
        unsigned* bar = b.bar;
        __builtin_amdgcn_s_waitcnt(0);
        unsigned nloc = b.st[0], nx = b.st[1];
        if (nloc == 0u) { xcd_barrier_complete(bar, b.x, nloc, nx); b.st[0] = nloc; b.st[1] = nx; }
        const unsigned old = xb_add(&bar[XB_XSUB(b.x)], 1u);
        const unsigned gen = old / nloc;
        if (old + 1u == (gen + 1u) * nloc) {
            __builtin_amdgcn_fence(__ATOMIC_RELEASE, "agent");
            asm volatile("s_waitcnt vmcnt(0)" ::: "memory");
            const unsigned og = xb_add(&bar[XB_TOP], 1u);
            const unsigned tg = og / nx;
            if (og + 1u == (tg + 1u) * nx) xb_add(&bar[XB_TOPGEN], 1u);
            else XB_SPIN(xb_ld(&bar[XB_TOPGEN]) == tg, bar);
            __builtin_amdgcn_fence(__ATOMIC_ACQUIRE, "agent");
            xb_add(&bar[XB_XGEN(b.x)], 1u);
            asm volatile("s_waitcnt vmcnt(0)" ::: "memory");
        } else {
            XB_SPIN(xb_ld(&bar[XB_XGEN(b.x)]) == gen, bar);
            __builtin_amdgcn_fence(__ATOMIC_ACQUIRE, "agent");
            asm volatile("s_waitcnt vmcnt(0)" ::: "memory");
        }
    }
    __syncthreads();
}
constexpr size_t WS_XBAR = 65536;
__device__ __forceinline__ void xbar_sync(LAS unsigned char* lds) {
    KParams* q = KP_FRESH(); XcdBarrier b; b.bar = (unsigned*)(q->ws + WS_CTL + WS_XBAR); b.x = xb_xcc_id(); b.st = (volatile LAS unsigned*)(lds + LDS_EXTRA + 12288); xcd_barrier(b);
}
__global__ void __launch_bounds__(512, 2) hymba_fwd(Params P) {
    __shared__ __attribute__((aligned(16))) unsigned char lds_raw[LDS_BYTES];
    LAS unsigned char* lds = (LAS unsigned char*)lds_raw;
    cg::grid_group grid = cg::this_grid();
    KParams* P0p = KP_FRESH();
    volatile LAS unsigned* xst = (volatile LAS unsigned*)(lds + LDS_EXTRA + 12288);
    if (threadIdx.x < 2) xst[threadIdx.x] = 0u;
    __syncthreads();
    (void)xcd_barrier_post((unsigned*)(P0p->ws + WS_CTL + WS_XBAR), xst);
#define XBAR() xbar_sync(lds)
    unsigned char* ws0 = P0p->ws;
#define P (*Pk)
#define ws (Pk->ws)
#define hbuf (Pk->out + O_Y)
#define hbA ((bf16_t*)(ws + WS_HBA))
#define hbB ((bf16_t*)(ws + WS_Q))
#define partA ((float*)(ws + WS_PARTA))
#define partB ((float*)(ws + WS_PARTB))
#define partQ ((float*)(ws + WS_PARTQ))
    KParams* Pk = P0p;
#if 0
    bf16_t* hbA = (bf16_t*)(ws + WS_HBA); bf16_t* hbB = (bf16_t*)(ws + WS_Q);
    float* partA = (float*)(ws + WS_PARTA); float* partB = (float*)(ws + WS_PARTB); float* partQ = (float*)(ws + WS_PARTQ);
#endif

#ifndef SKIP_P0
    p0_prologue(P, lds);
#endif
    if (ws0 == nullptr) grid_barrier(grid);
    XBAR();

    for (int l = 0; l < DEPTH; ++l) {
        Pk = KP_FRESH();
#ifndef SKIP_P1
        { int G = gridDim.x, bx = blockIdx.x; asm volatile("" : "+s"(G), "+s"(bx));
          pg8::Gemm g{hbA, (const bf16_t*)(ws + WS_WIN) + (size_t)l * NIN * DM, MROWS, NIN, DM}; pg8::StaticOrder S; S.init(MROWS, NIN, G, bx);
          EpiIn E{partA, (bf16_t*)(ws + WS_CQ), partQ, P.out + O_CKVP + (size_t)l * NP * 128, P.out + O_CKVS + (size_t)l * NS * 128,
                  P.out + O_KRP + (size_t)l * NP * 32, P.out + O_KRS + (size_t)l * NS * 32, (bf16_t*)(ws + WS_SGA), (bf16_t*)(ws + WS_U), (bf16_t*)(ws + WS_SGC)};
          pg8::gemm_phase(lds, g, S, E); }
#endif
        if (l == 0) { __syncthreads(); Pk = KP_FRESH(); p0b_wq(P, lds); }
        XBAR();
        Pk = KP_FRESH();
#ifndef SKIP_KV
        kvprep_phase(P, l, lds);
#endif
#ifndef SKIP_P2
        __syncthreads();
        Pk = KP_FRESH();
#ifndef SKIP_Q
        { int G = gridDim.x, bx = blockIdx.x; asm volatile("" : "+s"(G), "+s"(bx));
          pg8::Gemm g{(const bf16_t*)(ws + WS_CQ), (const bf16_t*)(ws + WS_WQ) + (size_t)l * NQ * 256, MROWS, NQ, 256}; pg8::StaticOrder S; S.init(MROWS, NQ, G, bx);
          EpiQ E{partQ, (bf16_t*)(ws + WS_Q), (const float*)(ws + WS_ROPE), (const float*)(ws + WS_ROPE) + 4096 * 16};
          pg8::gemm_phase(lds, g, S, E); }
#endif
#endif
        XBAR();
        Pk = KP_FRESH();
#ifndef SKIP_P4
        conv_phase(P, l, lds);
#endif
        __syncthreads();
        Pk = KP_FRESH();
#ifndef SKIP_P3
        attn_phase(P, l, lds);
#endif
        XBAR();
        Pk = KP_FRESH();
        { int G = gridDim.x, bx = blockIdx.x; asm volatile("" : "+s"(G), "+s"(bx));
          if (G > 8 && bx >= 4) {
              pg8::Gemm g{(const bf16_t*)(ws + WS_PB) + (size_t)l * MROWS * DPLE, (const bf16_t*)(ws + WS_WPE) + (size_t)l * DM * DPLE, MROWS, DM, DPLE};
              pg8::StaticOrder S; S.init(MROWS, DM, G - 4, bx - 4);
              EpiPe E{(bf16_t*)(ws + WS_PE)};
              pg8::gemm_phase(lds, g, S, E); }
          else if (G <= 8) {
              pg8::Gemm g{(const bf16_t*)(ws + WS_PB) + (size_t)l * MROWS * DPLE, (const bf16_t*)(ws + WS_WPE) + (size_t)l * DM * DPLE, MROWS, DM, DPLE};
              pg8::StaticOrder S; S.init(MROWS, DM, G, bx);
              EpiPe E{(bf16_t*)(ws + WS_PE)};
              pg8::gemm_phase(lds, g, S, E); } }
        __syncthreads();
        Pk = KP_FRESH();
#ifndef SKIP_P5
        { int G = gridDim.x, bx = blockIdx.x; asm volatile("" : "+s"(G), "+s"(bx));
          pg8::Gemm g{(const bf16_t*)(ws + WS_CAT), (const bf16_t*)(ws + WS_WOUT) + (size_t)l * DM * DM, MROWS, DM, DM}; pg8::StaticOrder S; S.init(MROWS, DM, G, bx);
          EpiOut E{P.in[0], P.in[1], l == 0 ? (const bf16_t*)nullptr : (const bf16_t*)hbA, hbB, partB};
          pg8::gemm_phase(lds, g, S, E); }
#endif
        XBAR();
        Pk = KP_FRESH();
#ifndef SKIP_P6
        { int G = gridDim.x, bx = blockIdx.x; asm volatile("" : "+s"(G), "+s"(bx));
          pg8::Gemm g{hbB, (const bf16_t*)(ws + WS_WPG) + (size_t)l * DM * DM, MROWS, DM, DM}; pg8::StaticOrder S; S.init(MROWS, DM, G, bx);
          EpiGate E{partB, (const bf16_t*)(ws + WS_PE), (const bf16_t*)hbB, hbA, partA};
          pg8::gemm_phase(lds, g, S, E); }
#endif
        XBAR();
    }
    Pk = KP_FRESH();
    final_phase(P);
#undef P
#undef ws
#undef hbuf
#undef hbA
#undef hbB
#undef partA
#undef partB
#undef partQ
}

extern "C" void kernel_launch(void* const* d_in, const int* in_sizes, int n_in, void* d_out, int out_size, void* d_ws, size_t ws_size, hipStream_t stream) {
    static int grid = 0;
    if (grid == 0) {
        int dev = 0, cus = 0, per_cu = 0;
        hipGetDevice(&dev);
        hipDeviceGetAttribute(&cus, hipDeviceAttributeMultiprocessorCount, dev);
        hipOccupancyMaxActiveBlocksPerMultiprocessor(&per_cu, (const void*)hymba_fwd, 512, 0);
        if (per_cu < 1) per_cu = 1;
        grid = cus * per_cu;
        if (ws_size < WS_END) { fprintf(stderr, "kernel_launch: workspace too small (%zu < %zu)\n", ws_size, (size_t)WS_END); grid = -1; }
    }
    if (grid < 0) return;
    Params p{};
    for (int i = 0; i < 24; ++i) p.in[i] = (const float*)d_in[i];
    p.out = (float*)d_out; p.ws = (unsigned char*)d_ws;
    for (int i = 0; i < 16; ++i) p.inv[i] = (float)pow(10000.0, -(double)i / 16.0);
    (void)hipMemsetAsync((char*)d_ws + WS_CTL + WS_XBAR, 0, 16384, stream);
    void* args[] = {&p};
    hipError_t e = hipLaunchCooperativeKernel((const void*)hymba_fwd, dim3(grid), dim3(512), args, 0, stream);
    if (e != hipSuccess) fprintf(stderr, "cooperative launch failed: %s (grid %d)\n", hipGetErrorString(e), grid);
}
```

```cpp
#include <hip/hip_runtime.h>
#include <hip/hip_cooperative_groups.h>
#include <cstdio>
#include <cstdint>
#include <cmath>
namespace cg = cooperative_groups;

#define LAS __attribute__((address_space(3)))
typedef unsigned short bf16_t;
typedef short bf16x8 __attribute__((ext_vector_type(8)));
typedef float f32x4 __attribute__((ext_vector_type(4)));
typedef float f32x2 __attribute__((ext_vector_type(2)));
typedef float f32x16 __attribute__((ext_vector_type(16)));
typedef unsigned u32x4 __attribute__((ext_vector_type(4)));
typedef unsigned u32x2 __attribute__((ext_vector_type(2)));

constexpr int DM = 1024, SEQ = 4096, NP = 65536, NS = 256, MROWS = NP + NS, DEPTH = 2;
constexpr int PAST = 2048, KVS = 2064, KVSP = 2112, DPLE = 256;
constexpr int NIN = 2560, NQ = 1280, DIN = 2464;
constexpr float EPS = 1e-6f;
constexpr float QSCALE = 0.10206207261596575f * 1.4426950408889634f;

constexpr size_t O_Y = 0, O_CKVP = 67371008, O_KRP = 84148224, O_CVP = 88342528, O_CKVS = 88834048, O_KRS = 88899584, O_CVS = 88915968;

constexpr size_t MiB = 1u << 20;
constexpr size_t WS_CTL = 0;
constexpr size_t WS_ROPE = 1 * MiB;
constexpr size_t WS_WIN = 2 * MiB;
constexpr size_t WS_WQ = 12 * MiB;
constexpr size_t WS_WOUT = 14 * MiB;
constexpr size_t WS_WPG = 18 * MiB;
constexpr size_t WS_WPE = 22 * MiB;
constexpr size_t WS_WUV = 23 * MiB;
constexpr size_t WS_PARTA = 24 * MiB;
constexpr size_t WS_PARTB = 29 * MiB;
constexpr size_t WS_PARTQ = 34 * MiB;
constexpr size_t WS_SSQA = 36 * MiB;
constexpr size_t WS_HBA = 39 * MiB;
constexpr size_t WS_Q = 168 * MiB;
constexpr size_t WS_CQ = 329 * MiB;
constexpr size_t WS_SGA = 362 * MiB;
constexpr size_t WS_U = 427 * MiB;
constexpr size_t WS_SGC = 492 * MiB;
constexpr size_t WS_CAT = 557 * MiB;
constexpr size_t WS_PE = 686 * MiB;
constexpr size_t WS_PB = 815 * MiB;
constexpr size_t WS_KP = 881 * MiB;
constexpr size_t WS_VTP = 921 * MiB;
constexpr size_t WS_KS = 953 * MiB;
constexpr size_t WS_VTS = 975 * MiB;
constexpr size_t WS_FOLD = 993 * MiB;
constexpr size_t WS_END = 995 * MiB;
constexpr size_t KP_LAYER = (size_t)NP * 160, VTP_LAYER = (size_t)16 * 128 * SEQ;
constexpr size_t KS_LAYER = (size_t)16 * KVSP * 160, VTS_LAYER = (size_t)16 * 128 * KVSP;

constexpr int LDS_BYTES = 147456;
constexpr int LDS_EXTRA = 131072;

struct Params {
    const float* in[24];
    float* out;
    unsigned char* ws;
    float inv[16];
};

typedef const __attribute__((address_space(4))) Params KParams;
#define KP_FRESH() ({ KParams* _p = (KParams*)__builtin_amdgcn_kernarg_segment_ptr(); asm volatile("" : "+s"(_p)); _p; })
__device__ __forceinline__ float wave_sum(float v) {
#pragma unroll
    for (int o = 1; o < 64; o <<= 1) v += __shfl_xor(v, o);
    return v;
}
typedef __bf16 bf16x2_t __attribute__((ext_vector_type(2)));
__device__ __forceinline__ unsigned cvt_pk_bf16(float lo, float hi) { f32x2 v = {lo, hi}; bf16x2_t b = __builtin_convertvector(v, bf16x2_t); return __builtin_bit_cast(unsigned, b); }
__device__ __forceinline__ float bf_lo(unsigned w) { return __uint_as_float(w << 16); }
__device__ __forceinline__ float bf_hi(unsigned w) { return __uint_as_float(w & 0xffff0000u); }
__device__ __forceinline__ float sigmoid_(float x) { return __builtin_amdgcn_rcpf(1.f + __expf(-x)); }
__device__ __forceinline__ float silu_(float x) { return x * sigmoid_(x); }
__device__ __forceinline__ int swap23(int p) { return (p & ~12) | ((p & 4) << 1) | ((p & 8) >> 1); }

namespace pg8 {
constexpr int BM = 256, BK = 64, HALF = 128, HTB = HALF * BK * 2, STAGE_BYTES = 8 * HTB, NXCD = 8, WGM = 8;
__host__ __device__ __forceinline__ int lds_byte(int r, int c) { const int st = (r >> 4) * 2 + (c >> 5), rr = r & 15, cc = c & 31, ob = rr * 64 + cc * 2; return st * 1024 + (ob ^ (((ob >> 9) & 1) << 5)); }
__host__ __device__ __forceinline__ void stage_rc(int b, int& R, int& C) { const int st = b / 1024, sb = b % 1024, swz = sb ^ (((sb >> 9) & 1) << 5); R = (st >> 1) * 16 + swz / 64; C = (st & 1) * 32 + (swz % 64) / 2; }
__host__ __device__ __forceinline__ int perm32(int rho) { const int n = rho >> 4, i = rho & 15; return 8 * (i >> 2) + 4 * n + (i & 3); }

struct Unit { int pm, pn; };
struct Gemm { const bf16_t* A; const bf16_t* Bt; int M, N, K; };

struct StaticOrder {
    int nM, nN, nwg, G, c;
    __device__ void init(int M, int N, int G_, int c_) { nM = M / BM; nN = N / BM; nwg = nM * nN; G = G_; c = c_; }
    __device__ bool next(int i, Unit& u) const {
        const long L = (long)i * G + c; if (L >= nwg) return false;
        int wgid = (int)L; { const int q = nwg / NXCD, r = nwg % NXCD, xcd = wgid % NXCD, off = wgid / NXCD; wgid = (xcd < r ? xcd * (q + 1) : r * (q + 1) + (xcd - r) * q) + off; }
        const int nig = WGM * nN, gid = wgid / nig, fm = gid * WGM, gsz = (nM - fm) < WGM ? (nM - fm) : WGM;
        u.pm = fm + ((wgid % nig) % gsz); u.pn = (wgid % nig) / gsz; return true;
    }
};

template <class Epi>
__device__ __forceinline__ void gemm_phase(LAS unsigned char* lds, const Gemm g, const StaticOrder& S, const Epi& E) {
    int tid = threadIdx.x; asm volatile("" : "+v"(tid));
    const int wid = __builtin_amdgcn_readfirstlane(tid >> 6), lane = tid & 63, wr = wid >> 2, wc = wid & 3, fr = lane & 15, fq = lane >> 4;
    int K = g.K; asm volatile("" : "+s"(K)); const int nt = K / BK;
    LAS float* rsl = (LAS float*)(lds + LDS_EXTRA);
    unsigned voffA[2], voffB[2];
#pragma unroll
    for (int i = 0; i < 2; ++i) { int R, C; stage_rc(tid * 16 + i * 8192, R, C); const int Rb = (R & ~31) + perm32(R & 31);
        voffA[i] = (unsigned)(R * K + C) * 2u; voffB[i] = (unsigned)(Rb * K + C) * 2u; }
    const size_t kstep = (size_t)(BK * 2);
    const size_t hstep = (size_t)HALF * K * 2;
    const size_t tstep = 2 * hstep;
    const unsigned ldsw = (unsigned)wid * 1024u;
    const int aoff = lds_byte(wr * 64 + fr, fq * 8), boff = lds_byte(wc * 32 + fr, fq * 8);
#define PG8_SA(b, h) (((b) * 2 + (h)) * HTB)
#define PG8_SB(b, h) ((4 + (b) * 2 + (h)) * HTB)
#define PG8_STAGE(bufoff, gbase, voff) do { _Pragma("unroll") for (int _i = 0; _i < 2; ++_i) \
        __builtin_amdgcn_global_load_lds((const unsigned*)((const char*)(gbase) + (voff)[_i]), (LAS unsigned*)(lds + (bufoff) + ldsw + _i * 8192), 16, 0, 0); } while (0)
#define PG8_LDA(dst, b, h) do { _Pragma("unroll") for (int m = 0; m < 4; ++m) _Pragma("unroll") for (int k = 0; k < 2; ++k) dst[m][k] = *(const LAS bf16x8*)(lds + PG8_SA(b, h) + aoff + m * 2048 + k * 1024); } while (0)
#define PG8_LDB(dst, b, h) do { _Pragma("unroll") for (int n = 0; n < 2; ++n) _Pragma("unroll") for (int k = 0; k < 2; ++k) dst[n][k] = *(const LAS bf16x8*)(lds + PG8_SB(b, h) + boff + n * 2048 + k * 1024); } while (0)
#define PG8_MMA(ai, bj, At, Bt) do { __builtin_amdgcn_s_setprio(1); _Pragma("unroll") for (int m = 0; m < 4; ++m) _Pragma("unroll") for (int n = 0; n < 2; ++n) _Pragma("unroll") for (int k = 0; k < 2; ++k) \
        acc[ai][bj][m][n] = __builtin_amdgcn_mfma_f32_16x16x32_bf16(Bt[n][k], At[m][k], acc[ai][bj][m][n], 0, 0, 0); __builtin_amdgcn_s_setprio(0); } while (0)
#define PG8_WAIT_V(n) asm volatile("s_waitcnt vmcnt(" #n ")" ::: "memory")
#define PG8_WAIT_L(n) asm volatile("s_waitcnt lgkmcnt(" #n ")" ::: "memory")
#define PG8_BAR __builtin_amdgcn_s_barrier()
#define PG8_SCHED __builtin_amdgcn_sched_barrier(0)
    Unit cur, nxt; int ui = 0;
    if (!S.next(0, cur)) return;
    f32x4 acc[2][2][4][2];
#pragma unroll
    for (int a = 0; a < 2; ++a)
#pragma unroll
        for (int b = 0; b < 2; ++b)
#pragma unroll
            for (int m = 0; m < 4; ++m)
#pragma unroll
                for (int n = 0; n < 2; ++n) acc[a][b][m][n] = (f32x4){0.f, 0.f, 0.f, 0.f};
    bf16x8 At[4][2], B0[2][2], B1[2][2];
    const char* cA = (const char*)g.A + (size_t)cur.pm * tstep; const char* cB = (const char*)g.Bt + (size_t)cur.pn * tstep;
    E.prep(cur, 0, rsl, tid);
    PG8_STAGE(PG8_SB(0, 0), cB, voffB); PG8_STAGE(PG8_SB(0, 1), cB + hstep, voffB); PG8_STAGE(PG8_SA(0, 0), cA, voffA); PG8_STAGE(PG8_SA(0, 1), cA + hstep, voffA);
    if (wr == 1) PG8_BAR;
    PG8_WAIT_V(2); PG8_BAR;
    PG8_STAGE(PG8_SB(1, 0), cB + kstep, voffB); PG8_STAGE(PG8_SA(1, 0), cA + kstep, voffA); PG8_STAGE(PG8_SB(1, 1), cB + hstep + kstep, voffB);
    PG8_WAIT_V(6); PG8_BAR;
    for (;;) {
        const bool has_next = S.next(ui + 1, nxt);
        const char* nA = has_next ? (const char*)g.A + (size_t)nxt.pm * tstep : cA; const char* nB = has_next ? (const char*)g.Bt + (size_t)nxt.pn * tstep : cB;
#pragma unroll 1
        for (int t = 0; t < nt; t += 2) {
            const bool last = (t == nt - 2);
            const char* a1 = cA + (size_t)(t + 1) * kstep;
            const char* a2 = last ? nA : cA + (size_t)(t + 2) * kstep; const char* b2 = last ? nB : cB + (size_t)(t + 2) * kstep;
            const char* a3 = a2 + kstep; const char* b3 = b2 + kstep;
            if (last && has_next) E.prep(nxt, (ui + 1) & 1, rsl, tid);
            PG8_LDB(B0, 0, 0); PG8_LDB(B1, 0, 1); PG8_SCHED; PG8_LDA(At, 0, 0); PG8_STAGE(PG8_SA(1, 1), a1 + hstep, voffA);
            PG8_WAIT_V(8); PG8_WAIT_L(0); PG8_BAR; PG8_MMA(0, 0, At, B0); PG8_MMA(0, 1, At, B1); PG8_BAR; PG8_SCHED;
            PG8_LDA(At, 0, 1); PG8_STAGE(PG8_SB(0, 0), b2, voffB); PG8_STAGE(PG8_SB(0, 1), b2 + hstep, voffB); PG8_STAGE(PG8_SA(0, 0), a2, voffA);
            PG8_WAIT_V(8); PG8_WAIT_L(0); PG8_BAR; PG8_MMA(1, 0, At, B0); PG8_MMA(1, 1, At, B1); PG8_BAR; PG8_SCHED;
            PG8_LDB(B0, 1, 0); PG8_LDB(B1, 1, 1); PG8_SCHED; PG8_LDA(At, 1, 0); PG8_STAGE(PG8_SA(0, 1), a2 + hstep, voffA);
            PG8_WAIT_V(8); PG8_WAIT_L(0); PG8_BAR; PG8_MMA(0, 0, At, B0); PG8_MMA(0, 1, At, B1); PG8_BAR; PG8_SCHED;
            PG8_LDA(At, 1, 1); PG8_STAGE(PG8_SB(1, 0), b3, voffB); PG8_STAGE(PG8_SB(1, 1), b3 + hstep, voffB); PG8_STAGE(PG8_SA(1, 0), a3, voffA);
            PG8_WAIT_V(8); PG8_WAIT_L(0); PG8_BAR; PG8_MMA(1, 0, At, B0); PG8_MMA(1, 1, At, B1); PG8_BAR; PG8_SCHED;
        }
        if (wr == 0) PG8_BAR;
        E(acc, cur, ui & 1, rsl, wr, wc, fr, fq);
        if (!has_next) break;
#pragma unroll
        for (int a = 0; a < 2; ++a)
#pragma unroll
            for (int b = 0; b < 2; ++b)
#pragma unroll
                for (int m = 0; m < 4; ++m)
#pragma unroll
                    for (int n = 0; n < 2; ++n) acc[a][b][m][n] = (f32x4){0.f, 0.f, 0.f, 0.f};
        cur = nxt; cA = nA; cB = nB; ++ui;
        if (wr == 1) PG8_BAR;
    }
    PG8_WAIT_V(0);
    PG8_BAR;
#undef PG8_SA
#undef PG8_SB
#undef PG8_STAGE
#undef PG8_LDA
#undef PG8_LDB
#undef PG8_MMA
#undef PG8_WAIT_V
#undef PG8_WAIT_L
#undef PG8_BAR
#undef PG8_SCHED
}
}
using pg8::Unit;

#define EPI_ROWS(...) \
    _Pragma("unroll") for (int ai = 0; ai < 2; ++ai) _Pragma("unroll") for (int m = 0; m < 4; ++m) { \
        const int rl = ai * 128 + wr * 64 + m * 16 + fr; const int row = u.pm * 256 + rl; __VA_ARGS__ if (m == 3) asm volatile("" ::: "memory"); }

__device__ __forceinline__ u32x4 pack8(f32x4 a, f32x4 b) { u32x4 w; w.x = cvt_pk_bf16(a[0], a[1]); w.y = cvt_pk_bf16(a[2], a[3]); w.z = cvt_pk_bf16(b[0], b[1]); w.w = cvt_pk_bf16(b[2], b[3]); return w; }
__device__ __forceinline__ float sumsq8(f32x4 a, f32x4 b) { return (a[0] * a[0] + a[1] * a[1]) + (a[2] * a[2] + a[3] * a[3]) + (b[0] * b[0] + b[1] * b[1]) + (b[2] * b[2] + b[3] * b[3]); }
__device__ __forceinline__ float red_fq(float s) { s += __shfl_xor(s, 16); s += __shfl_xor(s, 32); return s; }

struct EpiIn {
    const float* part_in;
    bf16_t* cq; float* part_q; float* ckv_p; float* ckv_s; float* kr_p; float* kr_s; bf16_t* sga; bf16_t* uu; bf16_t* sgc;
    __device__ __forceinline__ void prep(const Unit& u, int par, LAS float* rsl, int tid) const {
        if (tid < 256) { const int row = u.pm * 256 + tid; float s = 0.f;
#pragma unroll
            for (int j = 0; j < 4; ++j) { const f32x4 p = *(const f32x4*)(part_in + (size_t)row * 16 + 4 * j); s += (p[0] + p[1]) + (p[2] + p[3]); }
            rsl[par * 256 + tid] = rsqrtf(s * (1.0f / 1024.0f) + EPS); }
    }
    __device__ __forceinline__ void operator()(const f32x4 (&acc)[2][2][4][2], const Unit& u, int par, LAS float* rsl, int wr, int wc, int fr, int fq) const {
        const int pn = u.pn; const int cw = wc * 32 + 8 * fq;
        if (pn == 0) {
            EPI_ROWS( const float rs = rsl[par * 256 + rl]; float ss = 0.f;
                _Pragma("unroll") for (int bj = 0; bj < 2; ++bj) { const f32x4 v0 = acc[ai][bj][m][0] * rs, v1 = acc[ai][bj][m][1] * rs; ss += sumsq8(v0, v1);
                    *(u32x4*)(cq + (size_t)row * 256 + bj * 128 + cw) = pack8(v0, v1); }
                ss = red_fq(ss); if (fq == 0) part_q[(size_t)row * 4 + wc] = ss; )
        } else if (pn == 1) {
            EPI_ROWS( const float rs = rsl[par * 256 + rl];
                { float* d = (row < NP ? ckv_p + (size_t)row * 128 : ckv_s + (size_t)(row - NP) * 128) + cw;
                  *(f32x4*)d = acc[ai][0][m][0] * rs; *(f32x4*)(d + 4) = acc[ai][0][m][1] * rs; }
                if (wc == 0) { float* d = (row < NP ? kr_p + (size_t)row * 32 : kr_s + (size_t)(row - NP) * 32) + 8 * fq;
                  *(f32x4*)d = acc[ai][1][m][0] * rs; *(f32x4*)(d + 4) = acc[ai][1][m][1] * rs; } )
        } else if (pn < 4 || pn >= 8) {
            bf16_t* dst = (pn < 4) ? sga + (pn - 2) * 256 : sgc + (pn - 8) * 256;
            EPI_ROWS( const float rs = rsl[par * 256 + rl];
                _Pragma("unroll") for (int bj = 0; bj < 2; ++bj) { f32x4 v0 = acc[ai][bj][m][0] * rs, v1 = acc[ai][bj][m][1] * rs;
                    _Pragma("unroll") for (int e = 0; e < 4; ++e) { v0[e] = silu_(v0[e]); v1[e] = silu_(v1[e]); }
                    *(u32x4*)(dst + (size_t)row * 512 + bj * 128 + cw) = pack8(v0, v1); } )
        } else {
            bf16_t* dst = uu + (pn - 4) * 128;
            EPI_ROWS( const float rs = rsl[par * 256 + rl];
                f32x4 v0 = acc[ai][0][m][0] * rs, v1 = acc[ai][0][m][1] * rs; const f32x4 g0 = acc[ai][1][m][0] * rs, g1 = acc[ai][1][m][1] * rs;
                _Pragma("unroll") for (int e = 0; e < 4; ++e) { v0[e] *= sigmoid_(g0[e]); v1[e] *= sigmoid_(g1[e]); }
                *(u32x4*)(dst + (size_t)row * 512 + cw) = pack8(v0, v1); )
        }
    }
};

struct EpiQ {
    const float* part_q; bf16_t* Q; const float* cosT; const float* sinT;
    __device__ __forceinline__ void prep(const Unit& u, int par, LAS float* rsl, int tid) const {
        if (tid < 256) { const int row = u.pm * 256 + tid; const f32x4 p = *(const f32x4*)(part_q + (size_t)row * 4);
            rsl[par * 256 + tid] = rsqrtf(((p[0] + p[1]) + (p[2] + p[3])) * (1.0f / 256.0f) + EPS) * QSCALE; }
    }
    __device__ __forceinline__ void operator()(const f32x4 (&acc)[2][2][4][2], const Unit& u, int par, LAS float* rsl, int wr, int wc, int fr, int fq) const {
        const int pn = u.pn; const int cw = wc * 32 + 8 * fq;
        if (pn < 4) {
            EPI_ROWS( const float rs = rsl[par * 256 + rl];
                _Pragma("unroll") for (int bj = 0; bj < 2; ++bj)
                    *(u32x4*)(Q + (size_t)row * NQ + pn * 256 + bj * 128 + cw) = pack8(acc[ai][bj][m][0] * rs, acc[ai][bj][m][1] * rs); )
        } else {
            EPI_ROWS( const float rs = rsl[par * 256 + rl];
                const int pos = row < NP ? (row & (SEQ - 1)) : PAST + ((row - NP) & 15);
                const f32x4 cs = *(const f32x4*)(cosT + pos * 16 + 4 * fq), sn = *(const f32x4*)(sinT + pos * 16 + 4 * fq);
                _Pragma("unroll") for (int bj = 0; bj < 2; ++bj) { const f32x4 x1 = acc[ai][bj][m][0] * rs, x2 = acc[ai][bj][m][1] * rs;
                    const f32x4 o1 = x1 * cs - x2 * sn, o2 = x1 * sn + x2 * cs; const int head = bj * 4 + wc;
                    bf16_t* d = Q + (size_t)row * NQ + 1024 + head * 32 + 4 * fq;
                    u32x2 w1, w2; w1.x = cvt_pk_bf16(o1[0], o1[1]); w1.y = cvt_pk_bf16(o1[2], o1[3]); w2.x = cvt_pk_bf16(o2[0], o2[1]); w2.y = cvt_pk_bf16(o2[2], o2[3]);
                    *(u32x2*)d = w1; *(u32x2*)(d + 16) = w2; } )
        }
    }
};

struct EpiPe {
    bf16_t* pe;
    __device__ __forceinline__ void prep(const Unit&, int, LAS float*, int) const {}
    __device__ __forceinline__ void operator()(const f32x4 (&acc)[2][2][4][2], const Unit& u, int par, LAS float* rsl, int wr, int wc, int fr, int fq) const {
        const int cw = u.pn * 256 + wc * 32 + 8 * fq;
        EPI_ROWS(
            _Pragma("unroll") for (int bj = 0; bj < 2; ++bj) *(u32x4*)(pe + (size_t)row * DM + bj * 128 + cw) = pack8(acc[ai][bj][m][0], acc[ai][bj][m][1]); )
    }
};

struct EpiOut {
    const float* base_p; const float* base_s; const bf16_t* base_b; bf16_t* hb; float* part;
    __device__ __forceinline__ void prep(const Unit&, int, LAS float*, int) const {}
    __device__ __forceinline__ void operator()(const f32x4 (&acc)[2][2][4][2], const Unit& u, int par, LAS float* rsl, int wr, int wc, int fr, int fq) const {
        const int cw = u.pn * 256 + wc * 32 + 8 * fq;
        if (base_b == nullptr) {
            EPI_ROWS( const float* b = (row < NP ? base_p + (size_t)row * DM : base_s + (size_t)(row - NP) * DM) + cw; float ss = 0.f;
                _Pragma("unroll") for (int bj = 0; bj < 2; ++bj) { const f32x4 v0 = acc[ai][bj][m][0] + *(const f32x4*)(b + bj * 128), v1 = acc[ai][bj][m][1] + *(const f32x4*)(b + bj * 128 + 4);
                    *(u32x4*)(hb + (size_t)row * DM + bj * 128 + cw) = pack8(v0, v1); ss += sumsq8(v0, v1); }
                ss = red_fq(ss); if (fq == 0) part[(size_t)row * 16 + u.pn * 4 + wc] = ss; )
        } else {
            EPI_ROWS( float ss = 0.f;
                _Pragma("unroll") for (int bj = 0; bj < 2; ++bj) { const size_t off = (size_t)row * DM + bj * 128 + cw; const u32x4 bw = *(const u32x4*)(base_b + off);
                    const f32x4 v0 = acc[ai][bj][m][0] + (f32x4){bf_lo(bw.x), bf_hi(bw.x), bf_lo(bw.y), bf_hi(bw.y)}, v1 = acc[ai][bj][m][1] + (f32x4){bf_lo(bw.z), bf_hi(bw.z), bf_lo(bw.w), bf_hi(bw.w)};
                    *(u32x4*)(hb + off) = pack8(v0, v1); ss += sumsq8(v0, v1); }
                ss = red_fq(ss); if (fq == 0) part[(size_t)row * 16 + u.pn * 4 + wc] = ss; )
        }
    }
};

struct EpiGate {
    const float* part_in; const bf16_t* pe; const bf16_t* hin; bf16_t* hb; float* part;
    __device__ __forceinline__ void prep(const Unit& u, int par, LAS float* rsl, int tid) const {
        if (tid < 256) { const int row = u.pm * 256 + tid; float s = 0.f;
#pragma unroll
            for (int j = 0; j < 4; ++j) { const f32x4 p = *(const f32x4*)(part_in + (size_t)row * 16 + 4 * j); s += (p[0] + p[1]) + (p[2] + p[3]); }
            rsl[par * 256 + tid] = rsqrtf(s * (1.0f / 1024.0f) + EPS); }
    }
    __device__ __forceinline__ void operator()(const f32x4 (&acc)[2][2][4][2], const Unit& u, int par, LAS float* rsl, int wr, int wc, int fr, int fq) const {
        const int cw = u.pn * 256 + wc * 32 + 8 * fq;
        EPI_ROWS( const float rs = rsl[par * 256 + rl]; float ss = 0.f;
            _Pragma("unroll") for (int bj = 0; bj < 2; ++bj) { const size_t off = (size_t)row * DM + bj * 128 + cw;
                const u32x4 pw = *(const u32x4*)(pe + off); const u32x4 hw = *(const u32x4*)(hin + off);
                const f32x4 a0 = acc[ai][bj][m][0] * rs, a1 = acc[ai][bj][m][1] * rs; f32x4 v0, v1;
                v0[0] = bf_lo(hw.x) + sigmoid_(a0[0]) * bf_lo(pw.x); v0[1] = bf_hi(hw.x) + sigmoid_(a0[1]) * bf_hi(pw.x); v0[2] = bf_lo(hw.y) + sigmoid_(a0[2]) * bf_lo(pw.y); v0[3] = bf_hi(hw.y) + sigmoid_(a0[3]) * bf_hi(pw.y);
                v1[0] = bf_lo(hw.z) + sigmoid_(a1[0]) * bf_lo(pw.z); v1[1] = bf_hi(hw.z) + sigmoid_(a1[1]) * bf_hi(pw.z); v1[2] = bf_lo(hw.w) + sigmoid_(a1[2]) * bf_lo(pw.w); v1[3] = bf_hi(hw.w) + sigmoid_(a1[3]) * bf_hi(pw.w);
                *(u32x4*)(hb + off) = pack8(v0, v1); ss += sumsq8(v0, v1); }
            ss = red_fq(ss); if (fq == 0) part[(size_t)row * 16 + u.pn * 4 + wc] = ss; )
    }
};

__device__ __forceinline__ int in_src(int n) {
    if (n < 256) return n;
    if (n < 512) { const int j = n - 256; return j < 160 ? 256 + j : -1; }
    if (n < 1024) return 416 + (n - 512);
    if (n < 2048) { const int tt = (n - 1024) >> 8, j = (n - 1024) & 255; return j < 128 ? 928 + tt * 128 + j : 1440 + tt * 128 + (j - 128); }
    return 1952 + (n - 2048);
}
struct SrcIn { const float* w; const float* g; __device__ __forceinline__ float operator()(int k, int n) const { const int s = in_src(n); return s < 0 ? 0.f : w[(size_t)k * DIN + s] * g[k]; } };
struct SrcQ { const float* wq; const float* fold; const float* g;
    __device__ __forceinline__ float operator()(int k, int n) const {
        if (n < 1024) return fold[(size_t)k * 1024 + n];
        const int j = n - 1024, head = j >> 5, p = j & 31, ridx = (p >> 3) * 4 + (p & 3) + 16 * ((p >> 2) & 1);
        return wq[(size_t)k * 768 + head * 96 + 64 + ridx] * g[k];
    } };
struct SrcPlain { const float* w; int N; const float* g; __device__ __forceinline__ float operator()(int k, int n) const { const float v = w[(size_t)k * N + n]; return g ? v * g[k] : v; } };

template <class F>
__device__ __forceinline__ void transpose_w(const F& src, int K, int Nout, bf16_t* WT, LAS float* scr, int gw, int NGW, int lane) {
    const int nblk = Nout / 32, items = (K / 64) * nblk;
    for (int it = gw; it < items; it += NGW) {
        const int kb = it / nblk, nb = it % nblk, k0 = kb * 64, n0 = nb * 32;
#pragma unroll 4
        for (int i = 0; i < 32; ++i) { const int kk = 2 * i + (lane >> 5); scr[kk * 33 + (lane & 31)] = src(k0 + kk, n0 + (lane & 31)); }
        const int c = lane & 7;
#pragma unroll
        for (int j = 0; j < 4; ++j) { const int n = (lane >> 3) + 8 * j; const LAS float* s = scr + (8 * c) * 33 + n;
            u32x4 o; o.x = cvt_pk_bf16(s[0 * 33], s[1 * 33]); o.y = cvt_pk_bf16(s[2 * 33], s[3 * 33]); o.z = cvt_pk_bf16(s[4 * 33], s[5 * 33]); o.w = cvt_pk_bf16(s[6 * 33], s[7 * 33]);
            *(u32x4*)(WT + (size_t)(n0 + n) * K + k0 + 8 * c) = o; }
    }
}

__device__ __forceinline__ void vt_flush(const LAS float* scr, bf16_t* vt, size_t pitch, int t0, int lane) {
#pragma unroll
    for (int dd = 0; dd < 2; ++dd) { const int d = lane + 64 * dd; bf16_t* dst = vt + (size_t)d * pitch + t0;
#pragma unroll
        for (int q = 0; q < 4; ++q) { u32x4 w;
            w.x = cvt_pk_bf16(scr[(8 * q + 0) * 128 + d], scr[(8 * q + 1) * 128 + d]); w.y = cvt_pk_bf16(scr[(8 * q + 2) * 128 + d], scr[(8 * q + 3) * 128 + d]);
            w.z = cvt_pk_bf16(scr[(8 * q + 4) * 128 + d], scr[(8 * q + 5) * 128 + d]); w.w = cvt_pk_bf16(scr[(8 * q + 6) * 128 + d], scr[(8 * q + 7) * 128 + d]);
            *(u32x4*)(dst + 8 * q) = w; } }
}

__device__ __forceinline__ void p0_prologue(KParams& P, LAS unsigned char* lds) {
    int tid = threadIdx.x; asm volatile("" : "+v"(tid)); const int lane = tid & 63, gw = blockIdx.x * 8 + (tid >> 6), NGW = gridDim.x * 8;
    unsigned char* ws = P.ws;
    LAS float* scr = (LAS float*)(lds + (tid >> 6) * 16384);
    if (blockIdx.x == 0 && tid < 64) { unsigned* ctl = (unsigned*)(ws + WS_CTL); for (int j = tid; j < 16 * 64; j += 64) ctl[j] = 0u; }
    { float* fold = (float*)(ws + WS_FOLD);
      for (int it = gw; it < DEPTH * 8 * 32 * 2; it += NGW) { const int rb = it & 1, kc = (it >> 1) & 31, h = (it >> 6) & 7, l = it >> 9; const int r = rb * 64 + lane, k0 = kc * 8;
          const float* bp = P.in[12] + (size_t)l * 128 * 1024 + (size_t)r * 1024 + h * 128; f32x4 bv[16];
#pragma unroll
          for (int j = 0; j < 16; ++j) bv[j] = *(const f32x4*)(bp + 4 * j);
#pragma unroll 1
          for (int kk = 0; kk < 8; ++kk) { const int k = k0 + kk; const float* ap = P.in[10] + (size_t)l * 256 * 768 + (size_t)k * 768 + h * 96; float sm = 0.f;
#pragma unroll
              for (int j = 0; j < 16; ++j) { const f32x4 av = *(const f32x4*)(ap + 4 * j); sm += (av[0] * bv[j][0] + av[1] * bv[j][1]) + (av[2] * bv[j][2] + av[3] * bv[j][3]); }
              fold[((size_t)l * 256 + k) * 1024 + h * 128 + r] = sm * P.in[9][l * 256 + k]; } } }
    { float* cosT = (float*)(ws + WS_ROPE); float* sinT = cosT + 4096 * 16;
      for (int e = gw * 64 + lane; e < 4096 * 16; e += NGW * 64) { const int pos = e >> 4, i = e & 15;
          const float ang = (float)pos * P.inv[i];
          double rev = (double)ang * 0.15915494309189535; rev -= floor(rev);
          cosT[e] = __builtin_amdgcn_cosf((float)rev); sinT[e] = __builtin_amdgcn_sinf((float)rev); } }
    for (int l = 0; l < DEPTH; ++l) {
        { SrcIn s{P.in[8] + (size_t)l * DM * DIN, P.in[7] + l * DM}; transpose_w(s, DM, NIN, (bf16_t*)(ws + WS_WIN) + (size_t)l * NIN * DM, scr, gw, NGW, lane); }
        { SrcPlain s{P.in[19] + (size_t)l * DM * DM, DM, nullptr}; transpose_w(s, DM, DM, (bf16_t*)(ws + WS_WOUT) + (size_t)l * DM * DM, scr, gw, NGW, lane); }
        { SrcPlain s{P.in[22] + (size_t)l * DM * DM, DM, P.in[21] + l * DM}; transpose_w(s, DM, DM, (bf16_t*)(ws + WS_WPG) + (size_t)l * DM * DM, scr, gw, NGW, lane); }
        { SrcPlain s{P.in[20] + (size_t)l * DPLE * DM, DM, nullptr}; transpose_w(s, DPLE, DM, (bf16_t*)(ws + WS_WPE) + (size_t)l * DM * DPLE, scr, gw, NGW, lane); }
    }
    { bf16_t* wuv = (bf16_t*)(ws + WS_WUV);
      for (int e = gw * 64 + lane; e < DEPTH * 8 * 64 * 128; e += NGW * 64) { const int p = e & 127, v = (e >> 7) & 63, h = (e >> 13) & 7, l = e >> 16;
          const float x = P.in[12][(size_t)l * 128 * 1024 + (size_t)swap23(p) * 1024 + h * 128 + 64 + v]; wuv[e] = (bf16_t)(cvt_pk_bf16(x, 0.f) & 0xffffu); } }
    { bf16_t* hba = (bf16_t*)(ws + WS_HBA); float* part = (float*)(ws + WS_PARTA);
      for (int row = gw; row < MROWS; row += 2 * NGW) { const int row2 = row + NGW; const bool has2 = row2 < MROWS;
          const float* xa = row < NP ? P.in[0] + (size_t)row * DM : P.in[1] + (size_t)(row - NP) * DM;
          const float* xb = has2 ? (row2 < NP ? P.in[0] + (size_t)row2 * DM : P.in[1] + (size_t)(row2 - NP) * DM) : xa;
          f32x4 a[4], b[4];
#pragma unroll
          for (int j = 0; j < 4; ++j) { a[j] = *(const f32x4*)(xa + 4 * (lane + 64 * j)); b[j] = *(const f32x4*)(xb + 4 * (lane + 64 * j)); }
          float sa = 0.f, sb = 0.f;
#pragma unroll
          for (int j = 0; j < 4; ++j) { sa += (a[j][0] * a[j][0] + a[j][1] * a[j][1]) + (a[j][2] * a[j][2] + a[j][3] * a[j][3]); sb += (b[j][0] * b[j][0] + b[j][1] * b[j][1]) + (b[j][2] * b[j][2] + b[j][3] * b[j][3]);
              u32x2 w; w.x = cvt_pk_bf16(a[j][0], a[j][1]); w.y = cvt_pk_bf16(a[j][2], a[j][3]); *(u32x2*)(hba + (size_t)row * DM + 4 * (lane + 64 * j)) = w;
              if (has2) { u32x2 w2; w2.x = cvt_pk_bf16(b[j][0], b[j][1]); w2.y = cvt_pk_bf16(b[j][2], b[j][3]); *(u32x2*)(hba + (size_t)row2 * DM + 4 * (lane + 64 * j)) = w2; } }
          sa = wave_sum(sa); sb = wave_sum(sb);
          if (lane < 16) { part[(size_t)row * 16 + lane] = lane == 0 ? sa : 0.f; if (has2) part[(size_t)row2 * 16 + lane] = lane == 0 ? sb : 0.f; } } }
    { bf16_t* pb = (bf16_t*)(ws + WS_PB);
      for (int r0 = gw; r0 < DEPTH * MROWS; r0 += 8 * NGW) { f32x4 v[8];
#pragma unroll
          for (int u = 0; u < 8; ++u) { const int r = r0 + u * NGW; if (r < DEPTH * MROWS) { const int l = r / MROWS, row = r % MROWS;
              const float* pr = row < NP ? P.in[5] + ((size_t)l * NP + row) * DPLE : P.in[6] + ((size_t)l * NS + (row - NP)) * DPLE; v[u] = *(const f32x4*)(pr + 4 * lane); } }
#pragma unroll
          for (int u = 0; u < 8; ++u) { const int r = r0 + u * NGW; if (r < DEPTH * MROWS) { u32x2 w; w.x = cvt_pk_bf16(v[u][0], v[u][1]); w.y = cvt_pk_bf16(v[u][2], v[u][3]); *(u32x2*)(pb + (size_t)r * DPLE + 4 * lane) = w; } } } }
    { bf16_t* ks = (bf16_t*)(ws + WS_KS); bf16_t* vts = (bf16_t*)(ws + WS_VTS);
      for (int it = gw; it < DEPTH * 16 * 64; it += NGW) { const int tb = it & 63, sb = (it >> 6) & 15, l = it >> 10, t0 = tb * 32;
          const float* cc = P.in[2] + ((size_t)(l * 16 + sb) * PAST + t0) * 128; const float* cr = P.in[3] + ((size_t)(l * 16 + sb) * PAST + t0) * 32;
          bf16_t* kd = ks + (size_t)l * KS_LAYER + ((size_t)sb * KVSP + t0) * 160;
#pragma unroll 1
          for (int i0 = 0; i0 < 32; i0 += 8) { f32x2 c[8], r[8];
#pragma unroll
              for (int u = 0; u < 8; ++u) { c[u] = *(const f32x2*)(cc + (i0 + u) * 128 + 2 * lane); r[u] = *(const f32x2*)(cr + (i0 + u) * 32 + 2 * (lane & 15)); }
#pragma unroll
              for (int u = 0; u < 8; ++u) { const int i = i0 + u; *(unsigned*)(kd + i * 160 + 2 * lane) = cvt_pk_bf16(c[u][0], c[u][1]);
                  scr[i * 128 + 2 * lane] = c[u][0]; scr[i * 128 + 2 * lane + 1] = c[u][1];
                  if (lane < 16) *(unsigned*)(kd + i * 160 + 128 + 2 * lane) = cvt_pk_bf16(r[u][0], r[u][1]); } }
          vt_flush(scr, vts + (size_t)l * VTS_LAYER + (size_t)sb * 128 * KVSP, KVSP, t0, lane); }
      for (int e = gw * 64 + lane; e < DEPTH * 16 * 48 * 160; e += NGW * 64) { const int c = e % 160, t = (e / 160) % 48, sb = (e / (160 * 48)) % 16, l = e / (160 * 48 * 16);
          ks[(size_t)l * KS_LAYER + ((size_t)sb * KVSP + KVS + t) * 160 + c] = 0; }
      for (int e = gw * 64 + lane; e < DEPTH * 16 * 128 * 48; e += NGW * 64) { const int t = e % 48, d = (e / 48) % 128, sb = (e / (48 * 128)) % 16, l = e / (48 * 128 * 16);
          vts[(size_t)l * VTS_LAYER + ((size_t)sb * 128 + d) * KVSP + KVS + t] = 0; } }
}

__device__ __forceinline__ void p0b_wq(KParams& P, LAS unsigned char* lds) {
    int tid = threadIdx.x; asm volatile("" : "+v"(tid)); const int lane = tid & 63, gw = blockIdx.x * 8 + (tid >> 6), NGW = gridDim.x * 8;
    unsigned char* ws = P.ws; LAS float* scr = (LAS float*)(lds + (tid >> 6) * 16384);
    for (int l = 0; l < DEPTH; ++l) { SrcQ s{P.in[10] + (size_t)l * 256 * 768, (const float*)(ws + WS_FOLD) + (size_t)l * 256 * 1024, P.in[9] + l * 256};
        transpose_w(s, 256, NQ, (bf16_t*)(ws + WS_WQ) + (size_t)l * NQ * 256, scr, (gw + l * 1024) % NGW, NGW, lane); }
}
__device__ __forceinline__ void kv_row_regs(KParams& P, int l, f32x2 c, float x1, float x2, float cs, float sn, float* ckv, float* kr, bf16_t* krow, LAS float* scr_row, int lane) {
    const float ss = wave_sum(c[0] * c[0] + c[1] * c[1]); const float rs = rsqrtf(ss * (1.0f / 128.0f) + EPS);
    const f32x2 g = *(const f32x2*)(P.in[11] + l * 128 + 2 * lane); const float v0 = c[0] * rs * g[0], v1 = c[1] * rs * g[1];
    *(f32x2*)(ckv + 2 * lane) = (f32x2){v0, v1}; *(unsigned*)(krow + 2 * lane) = cvt_pk_bf16(v0, v1);
    scr_row[2 * lane] = v0; scr_row[2 * lane + 1] = v1;
    if (lane < 16) { const float o1 = x1 * cs - x2 * sn, o2 = x1 * sn + x2 * cs;
        kr[lane] = o1; kr[16 + lane] = o2; krow[128 + lane] = (bf16_t)(cvt_pk_bf16(o1, 0.f) & 0xffffu); krow[144 + lane] = (bf16_t)(cvt_pk_bf16(o2, 0.f) & 0xffffu); }
}
__device__ __forceinline__ void kv_row(KParams& P, int l, int row, int pos, float* ckv, float* kr, bf16_t* krow, LAS float* scr_row, int lane) {
    const float* cosT = (const float*)(P.ws + WS_ROPE); const float* sinT = cosT + 4096 * 16;
    const f32x2 c = *(const f32x2*)(ckv + 2 * lane); const int l15 = lane & 15;
    kv_row_regs(P, l, c, kr[l15], kr[16 + l15], cosT[pos * 16 + l15], sinT[pos * 16 + l15], ckv, kr, krow, scr_row, lane);
}
__device__ __forceinline__ void kvprep_phase(KParams& P, int l, LAS unsigned char* lds) {
    int tid = threadIdx.x; asm volatile("" : "+v"(tid)); const int lane = tid & 63, gw = blockIdx.x * 8 + (tid >> 6), NGW = gridDim.x * 8;
    unsigned char* ws = P.ws; LAS float* scr = (LAS float*)(lds + (tid >> 6) * 16384);
    bf16_t* kp = (bf16_t*)(ws + WS_KP) + (size_t)l * KP_LAYER; bf16_t* vtp = (bf16_t*)(ws + WS_VTP) + (size_t)l * VTP_LAYER;
    float* ckvp = P.out + O_CKVP + (size_t)l * NP * 128; float* krp = P.out + O_KRP + (size_t)l * NP * 32;
    for (int it = gw; it < NP / 32; it += NGW) { const int r0 = it * 32, b = r0 >> 12, t0 = r0 & (SEQ - 1);
        const float* cosT = (const float*)(ws + WS_ROPE); const float* sinT = cosT + 4096 * 16; const int l15 = lane & 15;
#pragma unroll 1
        for (int i0 = 0; i0 < 32; i0 += 16) { f32x2 c[16]; float x1[16], x2[16], cs[16], sn[16];
#pragma unroll
            for (int u = 0; u < 16; ++u) { const int row = r0 + i0 + u; c[u] = *(const f32x2*)(ckvp + (size_t)row * 128 + 2 * lane);
                x1[u] = krp[(size_t)row * 32 + l15]; x2[u] = krp[(size_t)row * 32 + 16 + l15]; cs[u] = cosT[(t0 + i0 + u) * 16 + l15]; sn[u] = sinT[(t0 + i0 + u) * 16 + l15]; }
#pragma unroll
            for (int u = 0; u < 16; ++u) { const int i = i0 + u, row = r0 + i;
                kv_row_regs(P, l, c[u], x1[u], x2[u], cs[u], sn[u], ckvp + (size_t)row * 128, krp + (size_t)row * 32, kp + (size_t)row * 160, scr + i * 128, lane); } }
        vt_flush(scr, vtp + (size_t)b * 128 * SEQ, SEQ, t0, lane); }
    float* ckvs = P.out + O_CKVS + (size_t)l * NS * 128; float* krs = P.out + O_KRS + (size_t)l * NS * 32;
    bf16_t* ks = (bf16_t*)(ws + WS_KS) + (size_t)l * KS_LAYER; bf16_t* vts = (bf16_t*)(ws + WS_VTS) + (size_t)l * VTS_LAYER;
    for (int r = gw; r < NS; r += NGW) { const int sb = r >> 4, i = r & 15; bf16_t* krow = ks + ((size_t)sb * KVSP + PAST + i) * 160;
        kv_row(P, l, NP + r, PAST + i, ckvs + (size_t)r * 128, krs + (size_t)r * 32, krow, scr, lane);
        vts[((size_t)sb * 128 + 2 * lane) * KVSP + PAST + i] = (bf16_t)(cvt_pk_bf16(scr[2 * lane], 0.f) & 0xffffu);
        vts[((size_t)sb * 128 + 2 * lane + 1) * KVSP + PAST + i] = (bf16_t)(cvt_pk_bf16(scr[2 * lane + 1], 0.f) & 0xffffu); }
}

constexpr int KT_PITCH = 336, VT_PITCH = 144, KT_BYTES = 64 * KT_PITCH, ABUF = KT_BYTES + 128 * VT_PITCH;
struct AUnit { const bf16_t* K; const bf16_t* VT; int vt_pitch, nt, kvlen, qrow0, nq; };

__device__ __forceinline__ void attn_unit(KParams& P, int l, const AUnit& U, LAS unsigned char* lds) {
    int tid = threadIdx.x; asm volatile("" : "+v"(tid));
    const int lane = tid & 63, h = __builtin_amdgcn_readfirstlane(tid >> 6), i = lane & 31, hi = lane >> 5;
    unsigned char* ws = P.ws;
    const bf16_t* Qb = (const bf16_t*)(ws + WS_Q);
    const bool valid = i < U.nq; const int row = U.qrow0 + (valid ? i : 0);
    bf16x8 qf[10];
    { const bf16_t* qr = Qb + (size_t)row * NQ;
#pragma unroll
      for (int s = 0; s < 8; ++s) qf[s] = *(const bf16x8*)(qr + h * 128 + 16 * s + 8 * hi);
#pragma unroll
      for (int s = 0; s < 2; ++s) qf[8 + s] = *(const bf16x8*)(qr + 1024 + h * 32 + 16 * s + 8 * hi);
      if (!valid) {
#pragma unroll
          for (int s = 0; s < 10; ++s) qf[s] = (bf16x8){0, 0, 0, 0, 0, 0, 0, 0}; } }
    u32x4 st[5];
    const int kr1 = tid / 20, kc1 = tid % 20, kr2 = (tid + 512) / 20, kc2 = (tid + 512) % 20, kr3 = ((tid & 255) + 1024) / 20, kc3 = ((tid & 255) + 1024) % 20;
    const int vd1 = tid >> 3, vc = tid & 7, vd2 = vd1 + 64;
#define A_LOAD(t) do { const bf16_t* kb = U.K + (size_t)(t) * 64 * 160; const bf16_t* vb = U.VT + (size_t)(t) * 64; \
        st[0] = *(const u32x4*)(kb + kr1 * 160 + kc1 * 8); st[1] = *(const u32x4*)(kb + kr2 * 160 + kc2 * 8); st[2] = *(const u32x4*)(kb + kr3 * 160 + kc3 * 8); \
        st[3] = *(const u32x4*)(vb + (size_t)vd1 * U.vt_pitch + vc * 8); st[4] = *(const u32x4*)(vb + (size_t)vd2 * U.vt_pitch + vc * 8); } while (0)
#define A_STORE(buf) do { LAS unsigned char* bb = lds + (buf) * ABUF; \
        *(LAS u32x4*)(bb + kr1 * KT_PITCH + kc1 * 16) = st[0]; *(LAS u32x4*)(bb + kr2 * KT_PITCH + kc2 * 16) = st[1]; *(LAS u32x4*)(bb + kr3 * KT_PITCH + kc3 * 16) = st[2]; \
        *(LAS u32x4*)(bb + KT_BYTES + vd1 * VT_PITCH + vc * 16) = st[3]; *(LAS u32x4*)(bb + KT_BYTES + vd2 * VT_PITCH + vc * 16) = st[4]; } while (0)
    A_LOAD(0); A_STORE(0);
    __syncthreads();
    f32x16 o[4];
#pragma unroll
    for (int d = 0; d < 4; ++d)
#pragma unroll
        for (int r = 0; r < 16; ++r) o[d][r] = 0.f;
    float mrun = -1e30f, lrun = 0.f;
    const int koff = swap23(i) * KT_PITCH + 16 * hi, voff = KT_BYTES + i * VT_PITCH + 16 * hi;
    for (int t = 0; t < U.nt; ++t) {
        const bool more = t + 1 < U.nt;
        if (more) A_LOAD(t + 1);
        const LAS unsigned char* bb = lds + (t & 1) * ABUF;
        f32x16 p0, p1;
#pragma unroll
        for (int r = 0; r < 16; ++r) { p0[r] = 0.f; p1[r] = 0.f; }
#pragma unroll
        for (int s = 0; s < 10; ++s) {
            const bf16x8 k0 = *(const LAS bf16x8*)(bb + koff + 32 * s), k1 = *(const LAS bf16x8*)(bb + koff + 32 * KT_PITCH + 32 * s);
            p0 = __builtin_amdgcn_mfma_f32_32x32x16_bf16(k0, qf[s], p0, 0, 0, 0);
            p1 = __builtin_amdgcn_mfma_f32_32x32x16_bf16(k1, qf[s], p1, 0, 0, 0);
        }
        if ((t + 1) * 64 > U.kvlen) {
            const int kb0 = t * 64 + 8 * hi;
#pragma unroll
            for (int r = 0; r < 16; ++r) { const int kv = kb0 + 16 * (r >> 3) + (r & 7); if (kv >= U.kvlen) p0[r] = -INFINITY; if (kv + 32 >= U.kvlen) p1[r] = -INFINITY; }
        }
        float mx = fmaxf(p0[0], p1[0]);
#pragma unroll
        for (int r = 1; r < 16; ++r) mx = fmaxf(mx, fmaxf(p0[r], p1[r]));
        { const auto rr = __builtin_amdgcn_permlane32_swap(__float_as_uint(mx), __float_as_uint(mx), false, false);
          mx = fmaxf(__uint_as_float(rr[0]), __uint_as_float(rr[1])); }
        const float mnew = fmaxf(mrun, mx); const float f = __builtin_amdgcn_exp2f(mrun - mnew); const bool grew = __any(mnew > mrun); mrun = mnew;
        f32x2 ps2 = {0.f, 0.f}; const f32x2 nm2 = {-mnew, -mnew};
#pragma unroll
        for (int r = 0; r < 16; r += 2) { f32x2 a = (f32x2){p0[r], p0[r + 1]} + nm2, b = (f32x2){p1[r], p1[r + 1]} + nm2;
            a[0] = __builtin_amdgcn_exp2f(a[0]); a[1] = __builtin_amdgcn_exp2f(a[1]); b[0] = __builtin_amdgcn_exp2f(b[0]); b[1] = __builtin_amdgcn_exp2f(b[1]);
            p0[r] = a[0]; p0[r + 1] = a[1]; p1[r] = b[0]; p1[r + 1] = b[1]; ps2 += a; ps2 += b; }
        const float ps = ps2[0] + ps2[1];
        lrun = lrun * f + ps;
        if (grew) {
#pragma unroll
            for (int d = 0; d < 4; ++d)
#pragma unroll
                for (int r = 0; r < 16; ++r) o[d][r] *= f;
        }
        bf16x8 pf[4];
        { u32x4 w;
          w.x = cvt_pk_bf16(p0[0], p0[1]); w.y = cvt_pk_bf16(p0[2], p0[3]); w.z = cvt_pk_bf16(p0[4], p0[5]); w.w = cvt_pk_bf16(p0[6], p0[7]); pf[0] = __builtin_bit_cast(bf16x8, w);
          w.x = cvt_pk_bf16(p0[8], p0[9]); w.y = cvt_pk_bf16(p0[10], p0[11]); w.z = cvt_pk_bf16(p0[12], p0[13]); w.w = cvt_pk_bf16(p0[14], p0[15]); pf[1] = __builtin_bit_cast(bf16x8, w);
          w.x = cvt_pk_bf16(p1[0], p1[1]); w.y = cvt_pk_bf16(p1[2], p1[3]); w.z = cvt_pk_bf16(p1[4], p1[5]); w.w = cvt_pk_bf16(p1[6], p1[7]); pf[2] = __builtin_bit_cast(bf16x8, w);
          w.x = cvt_pk_bf16(p1[8], p1[9]); w.y = cvt_pk_bf16(p1[10], p1[11]); w.z = cvt_pk_bf16(p1[12], p1[13]); w.w = cvt_pk_bf16(p1[14], p1[15]); pf[3] = __builtin_bit_cast(bf16x8, w); }
#pragma unroll
        for (int d = 0; d < 4; ++d)
#pragma unroll
            for (int ks = 0; ks < 4; ++ks) {
                const bf16x8 vf = *(const LAS bf16x8*)(bb + voff + d * 32 * VT_PITCH + 32 * ks);
                o[d] = __builtin_amdgcn_mfma_f32_32x32x16_bf16(vf, pf[ks], o[d], 0, 0, 0);
            }
        if (more) A_STORE((t + 1) & 1);
        __syncthreads();
    }
#undef A_LOAD
#undef A_STORE
    const float ltot = lrun + __shfl_xor(lrun, 32); const float linv = __builtin_amdgcn_rcpf(ltot);
    bf16x8 of[8];
#pragma unroll
    for (int kk = 0; kk < 8; ++kk) { const int d = kk >> 1, b = 8 * (kk & 1); u32x4 w;
        w.x = cvt_pk_bf16(o[d][b + 0] * linv, o[d][b + 1] * linv); w.y = cvt_pk_bf16(o[d][b + 2] * linv, o[d][b + 3] * linv);
        w.z = cvt_pk_bf16(o[d][b + 4] * linv, o[d][b + 5] * linv); w.w = cvt_pk_bf16(o[d][b + 6] * linv, o[d][b + 7] * linv); of[kk] = __builtin_bit_cast(bf16x8, w); }
    const bf16_t* wuv = (const bf16_t*)(ws + WS_WUV) + ((size_t)(l * 8 + h) * 64) * 128;
    f32x16 oa[2];
#pragma unroll
    for (int vb = 0; vb < 2; ++vb) {
#pragma unroll
        for (int r = 0; r < 16; ++r) oa[vb][r] = 0.f;
#pragma unroll
        for (int kk = 0; kk < 8; ++kk) { const bf16x8 wf = *(const bf16x8*)(wuv + (size_t)(32 * vb + i) * 128 + 16 * kk + 8 * hi);
            oa[vb] = __builtin_amdgcn_mfma_f32_32x32x16_bf16(wf, of[kk], oa[vb], 0, 0, 0); }
    }
    const bf16_t* sga = (const bf16_t*)(ws + WS_SGA) + (size_t)row * 512 + h * 64;
    bf16_t* cat = (bf16_t*)(ws + WS_CAT) + (size_t)row * DM + h * 64;
    float ss = 0.f;
#pragma unroll
    for (int vb = 0; vb < 2; ++vb)
#pragma unroll
        for (int rg = 0; rg < 4; ++rg) { const int v = 32 * vb + 8 * rg + 4 * hi; const u32x2 gw = *(const u32x2*)(sga + v);
            oa[vb][4 * rg + 0] *= bf_lo(gw.x); oa[vb][4 * rg + 1] *= bf_hi(gw.x); oa[vb][4 * rg + 2] *= bf_lo(gw.y); oa[vb][4 * rg + 3] *= bf_hi(gw.y);
            ss += (oa[vb][4 * rg + 0] * oa[vb][4 * rg + 0] + oa[vb][4 * rg + 1] * oa[vb][4 * rg + 1]) + (oa[vb][4 * rg + 2] * oa[vb][4 * rg + 2] + oa[vb][4 * rg + 3] * oa[vb][4 * rg + 3]); }
    ss += __shfl_xor(ss, 32);
    LAS float* ssqL = (LAS float*)(lds + LDS_EXTRA + 13312);
    if (hi == 0) ssqL[h * 32 + i] = ss;
    __syncthreads();
    float tot = 0.f;
#pragma unroll
    for (int hh = 0; hh < 8; ++hh) tot += ssqL[hh * 32 + i];
    const float rsa = rsqrtf(tot * (1.0f / 512.0f) + EPS);
    const float* lna = P.in[17] + l * 512 + h * 64;
    if (valid) {
#pragma unroll
        for (int vb = 0; vb < 2; ++vb)
#pragma unroll
            for (int rg = 0; rg < 4; ++rg) { const int v = 32 * vb + 8 * rg + 4 * hi; const f32x4 g4 = *(const f32x4*)(lna + v);
                u32x2 w; w.x = cvt_pk_bf16(oa[vb][4 * rg + 0] * rsa * g4[0], oa[vb][4 * rg + 1] * rsa * g4[1]); w.y = cvt_pk_bf16(oa[vb][4 * rg + 2] * rsa * g4[2], oa[vb][4 * rg + 3] * rsa * g4[3]);
                *(u32x2*)(cat + v) = w; }
    }
}

__device__ __forceinline__ void attn_phase(KParams& P, int l, LAS unsigned char* lds) {
    unsigned char* ws = P.ws;
    unsigned* ctl = (unsigned*)(ws + WS_CTL);
    LAS int* slot = (LAS int*)(lds + LDS_EXTRA + 4096);
    const unsigned xcc = (unsigned)__builtin_amdgcn_s_getreg((3 << 11) | 20) & 7u;
    for (int k = 0; k < 8; ++k) {
        const int x = (int)((xcc + k) & 7u);
        for (;;) {
            if (threadIdx.x == 0) *slot = (int)__hip_atomic_fetch_add(ctl + (l * 8 + x) * 64, 1u, __ATOMIC_RELAXED, __HIP_MEMORY_SCOPE_AGENT);
            __syncthreads();
            const int idx = *slot;
            __syncthreads();
            if (idx >= 258) break;
            AUnit U;
            if (idx < 2) { const int sb = 2 * x + idx; U.K = (const bf16_t*)(ws + WS_KS) + (size_t)l * KS_LAYER + (size_t)sb * KVSP * 160;
                U.VT = (const bf16_t*)(ws + WS_VTS) + (size_t)l * VTS_LAYER + (size_t)sb * 128 * KVSP; U.vt_pitch = KVSP; U.nt = KVSP / 64; U.kvlen = KVS; U.qrow0 = NP + sb * 16; U.nq = 16; }
            else { const int j = idx - 2, b = 2 * x + (j & 1), g = 127 - (j >> 1);
                U.K = (const bf16_t*)(ws + WS_KP) + (size_t)l * KP_LAYER + (size_t)b * SEQ * 160; U.VT = (const bf16_t*)(ws + WS_VTP) + (size_t)l * VTP_LAYER + (size_t)b * 128 * SEQ; U.vt_pitch = SEQ;
                U.nt = (g >> 1) + 1; U.kvlen = SEQ; U.qrow0 = b * SEQ + g * 32; U.nq = 32; }
            attn_unit(P, l, U, lds);
        }
    }
}

constexpr int UL_ROWS = 62, VL_PITCH = 516, VL_OFF = UL_ROWS * 512 * 2;
__device__ __forceinline__ void conv_phase(KParams& P, int l, LAS unsigned char* lds) {
    unsigned char* ws = P.ws; int tid = threadIdx.x; asm volatile("" : "+v"(tid)); const int lane = tid & 63, wave = tid >> 6;
    const bf16_t* ub = (const bf16_t*)(ws + WS_U); const bf16_t* sgc = (const bf16_t*)(ws + WS_SGC);
    bf16_t* cat = (bf16_t*)(ws + WS_CAT);
    LAS bf16_t* uL = (LAS bf16_t*)lds; LAS float* vL = (LAS float*)(lds + VL_OFF);
    const int cp = tid & 255, th = tid >> 8;
    const float* cw = P.in[13] + (size_t)l * 31 * 512; const f32x2 bias2 = *(const f32x2*)(P.in[14] + l * 512 + 2 * cp);
    f32x2 w2[31];
#pragma unroll
    for (int k = 0; k < 31; ++k) w2[k] = *(const f32x2*)(cw + k * 512 + 2 * cp);
    const int c0 = lane * 8;
    f32x4 lg[2], lb[2], lc[2];
#pragma unroll
    for (int e = 0; e < 2; ++e) { lg[e] = *(const f32x4*)(P.in[15] + l * 512 + c0 + 4 * e); lb[e] = *(const f32x4*)(P.in[16] + l * 512 + c0 + 4 * e);
        lc[e] = *(const f32x4*)(P.in[18] + l * 512 + c0 + 4 * e); }
    for (int it = blockIdx.x; it < 2048 + 16; it += gridDim.x) {
        const bool samp = it >= 2048; const int b = samp ? it - 2048 : it >> 7, t0 = samp ? 0 : (it & 127) * 32;
        const size_t rowbase = samp ? (size_t)NP + b * 16 : (size_t)b * SEQ + t0;
        { u32x4 sv[8];
#pragma unroll
          for (int k = 0; k < 8; ++k) { const int idx = tid + 512 * k; const int j = idx >> 6, ch = idx & 63; u32x4 v = (u32x4){0u, 0u, 0u, 0u};
              if (idx < UL_ROWS * 64) {
                  if (!samp) { const int t = t0 - 30 + j; if (t >= 0) v = *(const u32x4*)(ub + ((size_t)b * SEQ + t) * 512 + ch * 8); }
                  else if (j < 30) { const float* sp = P.in[4] + ((size_t)(l * 16 + b) * 30 + j) * 512 + ch * 8; const f32x4 a = *(const f32x4*)sp, bq = *(const f32x4*)(sp + 4); v = pack8(a, bq); }
                  else if (j < 46) v = *(const u32x4*)(ub + ((size_t)NP + b * 16 + (j - 30)) * 512 + ch * 8); }
              sv[k] = v; }
#pragma unroll
          for (int k = 0; k < 8; ++k) { const int idx = tid + 512 * k; if (idx < UL_ROWS * 64) *(LAS u32x4*)(uL + (idx >> 6) * 512 + (idx & 63) * 8) = sv[k]; } }
        __syncthreads();
#pragma unroll 1
        for (int g = 0; g < 2; ++g) { const int tb = 16 * th + 8 * g;
            f32x2 x[38];
#pragma unroll
            for (int q = 0; q < 38; ++q) { const unsigned wv = *(const LAS unsigned*)(uL + (tb + q) * 512 + 2 * cp); x[q] = (f32x2){__uint_as_float(wv << 16), __uint_as_float(wv & 0xffff0000u)}; }
#pragma unroll
            for (int o = 0; o < 8; ++o) { f32x2 a = bias2;
#pragma unroll
                for (int k = 0; k < 31; ++k) a += w2[k] * x[o + k];
                *(LAS f32x2*)(vL + (tb + o) * VL_PITCH + 2 * cp) = a; }
        }
        if (!samp) { if (t0 == SEQ - 32) { float* cs = P.out + O_CVP + ((size_t)(l * 16 + b) * 30) * 512 + tid;
#pragma unroll 1
                for (int j = 0; j < 30; ++j) cs[(size_t)j * 512] = __uint_as_float((unsigned)uL[(32 + j) * 512 + tid] << 16); } }
        else { float* cs = P.out + O_CVS + ((size_t)(l * 16 + b) * 30) * 512 + tid; const float* s = P.in[4] + ((size_t)(l * 16 + b) * 30 + 16) * 512 + tid;
#pragma unroll 1
            for (int j = 0; j < 14; ++j) cs[(size_t)j * 512] = s[(size_t)j * 512];
#pragma unroll 1
            for (int j = 0; j < 16; ++j) cs[(size_t)(14 + j) * 512] = __uint_as_float((unsigned)uL[(30 + j) * 512 + tid] << 16); }
        __syncthreads();
        const int ntok = samp ? 16 : 32;
        u32x4 gqp[4];
#pragma unroll
        for (int ti = 0; ti < 4; ++ti) gqp[ti] = *(const u32x4*)(sgc + (rowbase + wave + 8 * ti) * 512 + c0);
#pragma unroll
        for (int ti = 0; ti < 4; ++ti) { const int tt = wave + 8 * ti; if (tt >= ntok) break; const size_t row = rowbase + tt;
            f32x4 v[2]; v[0] = *(const LAS f32x4*)(vL + tt * VL_PITCH + c0); v[1] = *(const LAS f32x4*)(vL + tt * VL_PITCH + c0 + 4);
            const float mean = wave_sum((v[0][0] + v[0][1]) + (v[0][2] + v[0][3]) + (v[1][0] + v[1][1]) + (v[1][2] + v[1][3])) * (1.0f / 512.0f);
            v[0] = v[0] - mean; v[1] = v[1] - mean;
            const float var = wave_sum(sumsq8(v[0], v[1])) * (1.0f / 512.0f); const float rstd = rsqrtf(var + EPS);
            const u32x4 gq = gqp[ti]; const float gcv[8] = {bf_lo(gq.x), bf_hi(gq.x), bf_lo(gq.y), bf_hi(gq.y), bf_lo(gq.z), bf_hi(gq.z), bf_lo(gq.w), bf_hi(gq.w)};
#pragma unroll
            for (int e = 0; e < 2; ++e)
#pragma unroll
                for (int q = 0; q < 4; ++q) { const float y = v[e][q] * rstd * lg[e][q] + lb[e][q]; v[e][q] = silu_(y) * gcv[4 * e + q]; }
            const float rs = rsqrtf(wave_sum(sumsq8(v[0], v[1])) * (1.0f / 512.0f) + EPS);
            *(u32x4*)(cat + row * DM + 512 + c0) = pack8(v[0] * rs * lc[0], v[1] * rs * lc[1]);
        }
        __syncthreads();
    }
}

__device__ __forceinline__ void final_phase(KParams& P) {
    int tid = threadIdx.x; asm volatile("" : "+v"(tid)); const int lane = tid & 63, gw = blockIdx.x * 8 + (tid >> 6), NGW = gridDim.x * 8;
    const float* g = P.in[23]; const bf16_t* hb = (const bf16_t*)(P.ws + WS_HBA);
    f32x4 gv[4];
#pragma unroll
    for (int j = 0; j < 4; ++j) gv[j] = *(const f32x4*)(g + 16 * lane + 4 * j);
    for (int row = gw; row < MROWS; row += 2 * NGW) { const int row2 = row + NGW; const bool has2 = row2 < MROWS;
        const u32x4 a0 = *(const u32x4*)(hb + (size_t)row * DM + 16 * lane), a1 = *(const u32x4*)(hb + (size_t)row * DM + 16 * lane + 8);
        u32x4 b0 = a0, b1 = a1; if (has2) { b0 = *(const u32x4*)(hb + (size_t)row2 * DM + 16 * lane); b1 = *(const u32x4*)(hb + (size_t)row2 * DM + 16 * lane + 8); }
#pragma unroll
        for (int u = 0; u < 2; ++u) { if (u == 1 && !has2) break; const u32x4 w0 = u ? b0 : a0, w1 = u ? b1 : a1; const int rr = u ? row2 : row;
            f32x4 v[4] = {{bf_lo(w0.x), bf_hi(w0.x), bf_lo(w0.y), bf_hi(w0.y)}, {bf_lo(w0.z), bf_hi(w0.z), bf_lo(w0.w), bf_hi(w0.w)}, {bf_lo(w1.x), bf_hi(w1.x), bf_lo(w1.y), bf_hi(w1.y)}, {bf_lo(w1.z), bf_hi(w1.z), bf_lo(w1.w), bf_hi(w1.w)}};
            float sq = 0.f;
#pragma unroll
            for (int j = 0; j < 4; ++j) sq += (v[j][0] * v[j][0] + v[j][1] * v[j][1]) + (v[j][2] * v[j][2] + v[j][3] * v[j][3]);
            const float rs = rsqrtf(wave_sum(sq) * (1.0f / 1024.0f) + EPS); float* xr = P.out + O_Y + (size_t)rr * DM + 16 * lane;
#pragma unroll
            for (int j = 0; j < 4; ++j) *(f32x4*)(xr + 4 * j) = v[j] * rs * gv[j]; } }
}

__device__ __forceinline__ void grid_barrier(cg::grid_group& grid) {
    asm volatile("s_waitcnt vmcnt(0) lgkmcnt(0)" ::: "memory");
    __syncthreads();
    if (threadIdx.x < 64) { __builtin_amdgcn_fence(__ATOMIC_RELEASE, "agent"); asm volatile("s_waitcnt vmcnt(0)" ::: "memory"); }
    grid.sync();
    __builtin_amdgcn_fence(__ATOMIC_ACQUIRE, "agent");
    asm volatile("s_waitcnt vmcnt(0)" ::: "memory");
    __syncthreads();
}


#define XB_TMO      128
#define XB_XCNT(j)  (256  + 64 * (j))
#define XB_XSUB(j)  (1280 + 64 * (j))
#define XB_XGEN(j)  (2304 + 64 * (j))
#define XB_TOP      3328
#define XB_TOPGEN   3392
#define XCD_BAR_WORDS 3456
#define XB_SPIN_CAP (1u << 18)
__device__ __forceinline__ unsigned xb_ld(unsigned* p)              { return __hip_atomic_load(p, __ATOMIC_RELAXED, __HIP_MEMORY_SCOPE_AGENT); }
__device__ __forceinline__ unsigned xb_add(unsigned* p, unsigned v) { return __hip_atomic_fetch_add(p, v, __ATOMIC_RELAXED, __HIP_MEMORY_SCOPE_AGENT); }
__device__ __forceinline__ unsigned xb_xcc_id() { return (unsigned)__builtin_amdgcn_s_getreg((3 << 11) | 20) & 0xFu; }
#define XB_SPIN(cond, bar) do { unsigned _sp = 0; while (cond) { __builtin_amdgcn_s_sleep(1); \
    if ((++_sp & 255u) == 0u) { if (xb_ld(&(bar)[XB_TMO])) break; if (_sp > XB_SPIN_CAP) { atomicAdd(&(bar)[XB_TMO], 1u); break; } } } } while (0)
struct XcdBarrier { unsigned* bar; unsigned x; volatile LAS unsigned* st; };
__device__ __forceinline__ XcdBarrier xcd_barrier_post(unsigned* bar, volatile LAS unsigned* st) {
    XcdBarrier b; b.bar = bar; b.x = xb_xcc_id(); b.st = st;
    if (threadIdx.x == 0) (void)xb_add(&bar[XB_XCNT(b.x)], 1u);
    return b;
}
__device__ __forceinline__ void xcd_barrier_complete(unsigned* bar, unsigned x, unsigned& nloc, unsigned& nx) {
    const unsigned G = gridDim.x * gridDim.y * gridDim.z;
    unsigned sum, cnt, mine, sp = 0u;
    for (;;) {
        sum = 0u; cnt = 0u; mine = 0u;
#pragma unroll
        for (unsigned j = 0; j < 16; ++j) { const unsigned c = xb_ld(&bar[XB_XCNT(j)]); sum += c; cnt += (c > 0u) ? 1u : 0u; mine = (j == x) ? c : mine; }
        if (sum == G) break;
        __builtin_amdgcn_s_sleep(1);
        if ((++sp & 255u) == 0u) { if (xb_ld(&bar[XB_TMO])) break; if (sp > XB_SPIN_CAP) { atomicAdd(&bar[XB_TMO], 1u); break; } }
    }
    nloc = mine > 0u ? mine : 1u; nx = cnt > 0u ? cnt : 1u;
}
__device__ __forceinline__ void xcd_barrier(const XcdBarrier& b) {
    asm volatile("s_waitcnt vmcnt(0)" ::: "memory");
    __syncthreads();
    if (threadIdx.x == 0) {
        unsigned* bar = b.bar;
        __builtin_amdgcn_s_waitcnt(0);
        unsigned nloc = b.st[0], nx = b.st[1];
        if (nloc == 0u) { xcd_barrier_complete(bar, b.x, nloc, nx); b.st[0] = nloc; b.st[1] = nx; }
        const unsigned old = xb_add(&bar[XB_XSUB(b.x)], 1u);
        const unsigned gen = old / nloc;
        if (old + 1u == (gen + 1u) * nloc) {
            __builtin_amdgcn_fence(__ATOMIC_RELEASE, "agent");
            asm volatile("s_waitcnt vmcnt(0)" ::: "memory");
            const unsigned og = xb_add(&bar[XB_TOP], 1u);
            const unsigned tg = og / nx;
            if (og + 1u == (tg + 1u) * nx) xb_add(&bar[XB_TOPGEN], 1u);
            else XB_SPIN(xb_ld(&bar[XB_TOPGEN]) == tg, bar);
            __builtin_amdgcn_fence(__ATOMIC_ACQUIRE, "agent");
            xb_add(&bar[XB_XGEN(b.x)], 1u);
            asm volatile("s_waitcnt vmcnt(0)" ::: "memory");
        } else {
            XB_SPIN(xb_ld(&bar[XB_XGEN(b.x)]) == gen, bar);
            __builtin_amdgcn_fence(__ATOMIC_ACQUIRE, "agent");
            asm volatile("s_waitcnt vmcnt(0)" ::: "memory");
        }
    }
    __syncthreads();
}
constexpr size_t WS_XBAR = 65536;
__device__ __forceinline__ void xbar_sync(LAS unsigned char* lds) {
    KParams* q = KP_FRESH(); XcdBarrier b; b.bar = (unsigned*)(q->ws + WS_CTL + WS_XBAR); b.x = xb_xcc_id(); b.st = (volatile LAS unsigned*)(lds + LDS_EXTRA + 12288); xcd_barrier(b);
}
__global__ void __launch_bounds__(512, 2) hymba_fwd(Params P) {
    __shared__ __attribute__((aligned(16))) unsigned char lds_raw[LDS_BYTES];
    LAS unsigned char* lds = (LAS unsigned char*)lds_raw;
    cg::grid_group grid = cg::this_grid();
    KParams* P0p = KP_FRESH();
    volatile LAS unsigned* xst = (volatile LAS unsigned*)(lds + LDS_EXTRA + 12288);
    if (threadIdx.x < 2) xst[threadIdx.x] = 0u;
    __syncthreads();
    (void)xcd_barrier_post((unsigned*)(P0p->ws + WS_CTL + WS_XBAR), xst);
#define XBAR() xbar_sync(lds)
    unsigned char* ws0 = P0p->ws;
#define P (*Pk)
#define ws (Pk->ws)
#define hbuf (Pk->out + O_Y)
#define hbA ((bf16_t*)(ws + WS_HBA))
#define hbB ((bf16_t*)(ws + WS_Q))
#define partA ((float*)(ws + WS_PARTA))
#define partB ((float*)(ws + WS_PARTB))
#define partQ ((float*)(ws + WS_PARTQ))
    KParams* Pk = P0p;
#if 0
    bf16_t* hbA = (bf16_t*)(ws + WS_HBA); bf16_t* hbB = (bf16_t*)(ws + WS_Q);
    float* partA = (float*)(ws + WS_PARTA); float* partB = (float*)(ws + WS_PARTB); float* partQ = (float*)(ws + WS_PARTQ);
#endif

#ifndef SKIP_P0
    p0_prologue(P, lds);
#endif
    if (ws0 == nullptr) grid_barrier(grid);
    XBAR();

    for (int l = 0; l < DEPTH; ++l) {
        Pk = KP_FRESH();
#ifndef SKIP_P1
        { int G = gridDim.x, bx = blockIdx.x; asm volatile("" : "+s"(G), "+s"(bx));
          pg8::Gemm g{hbA, (const bf16_t*)(ws + WS_WIN) + (size_t)l * NIN * DM, MROWS, NIN, DM}; pg8::StaticOrder S; S.init(MROWS, NIN, G, bx);
          EpiIn E{partA, (bf16_t*)(ws + WS_CQ), partQ, P.out + O_CKVP + (size_t)l * NP * 128, P.out + O_CKVS + (size_t)l * NS * 128,
                  P.out + O_KRP + (size_t)l * NP * 32, P.out + O_KRS + (size_t)l * NS * 32, (bf16_t*)(ws + WS_SGA), (bf16_t*)(ws + WS_U), (bf16_t*)(ws + WS_SGC)};
          pg8::gemm_phase(lds, g, S, E); }
#endif
        if (l == 0) { __syncthreads(); Pk = KP_FRESH(); p0b_wq(P, lds); }
        XBAR();
        Pk = KP_FRESH();
        { int G = gridDim.x, bx = blockIdx.x; asm volatile("" : "+s"(G), "+s"(bx));
          pg8::Gemm g{(const bf16_t*)(ws + WS_CQ), (const bf16_t*)(ws + WS_WQ) + (size_t)l * NQ * 256, MROWS, NQ, 256}; pg8::StaticOrder S; S.init(MROWS, NQ, G, bx);
          EpiQ E{partQ, (bf16_t*)(ws + WS_Q), (const float*)(ws + WS_ROPE), (const float*)(ws + WS_ROPE) + 4096 * 16};
          pg8::gemm_phase(lds, g, S, E); }
        __syncthreads();
        Pk = KP_FRESH();
        kvprep_phase(P, l, lds);
        XBAR();
        Pk = KP_FRESH();
#ifndef SKIP_P4
        conv_phase(P, l, lds);
#endif
        __syncthreads();
        Pk = KP_FRESH();
#ifndef SKIP_P3
        attn_phase(P, l, lds);
#endif
        XBAR();
        Pk = KP_FRESH();
        { int G = gridDim.x, bx = blockIdx.x; asm volatile("" : "+s"(G), "+s"(bx));
          if (G > 8 && bx >= 4) {
              pg8::Gemm g{(const bf16_t*)(ws + WS_PB) + (size_t)l * MROWS * DPLE, (const bf16_t*)(ws + WS_WPE) + (size_t)l * DM * DPLE, MROWS, DM, DPLE};
              pg8::StaticOrder S; S.init(MROWS, DM, G - 4, bx - 4);
              EpiPe E{(bf16_t*)(ws + WS_PE)};
              pg8::gemm_phase(lds, g, S, E); }
          else if (G <= 8) {
              pg8::Gemm g{(const bf16_t*)(ws + WS_PB) + (size_t)l * MROWS * DPLE, (const bf16_t*)(ws + WS_WPE) + (size_t)l * DM * DPLE, MROWS, DM, DPLE};
              pg8::StaticOrder S; S.init(MROWS, DM, G, bx);
              EpiPe E{(bf16_t*)(ws + WS_PE)};
              pg8::gemm_phase(lds, g, S, E); } }
        __syncthreads();
        Pk = KP_FRESH();
#ifndef SKIP_P5
        { int G = gridDim.x, bx = blockIdx.x; asm volatile("" : "+s"(G), "+s"(bx));
          pg8::Gemm g{(const bf16_t*)(ws + WS_CAT), (const bf16_t*)(ws + WS_WOUT) + (size_t)l * DM * DM, MROWS, DM, DM}; pg8::StaticOrder S; S.init(MROWS, DM, G, bx);
          EpiOut E{P.in[0], P.in[1], l == 0 ? (const bf16_t*)nullptr : (const bf16_t*)hbA, hbB, partB};
          pg8::gemm_phase(lds, g, S, E); }
#endif
        XBAR();
        Pk = KP_FRESH();
#ifndef SKIP_P6
        { int G = gridDim.x, bx = blockIdx.x; asm volatile("" : "+s"(G), "+s"(bx));
          pg8::Gemm g{hbB, (const bf16_t*)(ws + WS_WPG) + (size_t)l * DM * DM, MROWS, DM, DM}; pg8::StaticOrder S; S.init(MROWS, DM, G, bx);
          EpiGate E{partB, (const bf16_t*)(ws + WS_PE), (const bf16_t*)hbB, hbA, partA};
          pg8::gemm_phase(lds, g, S, E); }
#endif
        XBAR();
    }
    Pk = KP_FRESH();
    final_phase(P);
#undef P
#undef ws
#undef hbuf
#undef hbA
#undef hbB
#undef partA
#undef partB
#undef partQ
}

extern "C" void kernel_launch(void* const* d_in, const int* in_sizes, int n_in, void* d_out, int out_size, void* d_ws, size_t ws_size, hipStream_t stream) {
    static int grid = 0;
    if (grid == 0) {
        int dev = 0, cus = 0, per_cu = 0;
        hipGetDevice(&dev);
        hipDeviceGetAttribute(&cus, hipDeviceAttributeMultiprocessorCount, dev);
        hipOccupancyMaxActiveBlocksPerMultiprocessor(&per_cu, (const void*)hymba_fwd, 512, 0);
        if (per_cu < 1) per_cu = 1;
        grid = cus * per_cu;
        if (ws_size < WS_END) { fprintf(stderr, "kernel_launch: workspace too small (%zu < %zu)\n", ws_size, (size_t)WS_END); grid = -1; }
    }
    if (grid < 0) return;
    Params p{};
    for (int i = 0; i < 24; ++i) p.in[i] = (const float*)d_in[i];
    p.out = (float*)d_out; p.ws = (unsigned char*)d_ws;
    for (int i = 0; i < 16; ++i) p.inv[i] = (float)pow(10000.0, -(double)i / 16.0);
    (void)hipMemsetAsync((char*)d_ws + WS_CTL + WS_XBAR, 0, 16384, stream);
    void* args[] = {&p};
    hipError_t e = hipLaunchCooperativeKernel((const void*)hymba_fwd, dim3(grid), dim3(512), args, 0, stream);
    if (e != hipSuccess) fprintf(stderr, "cooperative launch failed: %s (grid %d)\n", hipGetErrorString(e), grid);
}
```
